# Optimizing an MI355X kernel written in HIP

```python
import math
import jax, jax.numpy as jnp
from jax import lax
import numpy as np

D_MODEL = 1024
BATCH = 16
SEQ = 2048
DEPTH = 1

MLA_HEADS = 4
Q_LORA_RANK = 256
KV_LORA_RANK = 256
QK_NOPE_DIM = 128
QK_ROPE_DIM = 64
QK_HEAD_DIM = QK_NOPE_DIM + QK_ROPE_DIM
V_HEAD_DIM = 128
MLA_WIDTH = MLA_HEADS * V_HEAD_DIM
ROPE_THETA = 10000.0
Q_BLOCK = 128
GDN_HEADS = 4
GDN_HEAD_DIM = 128
GDN_WIDTH = GDN_HEADS * GDN_HEAD_DIM
CONV_WIDTH = 4
CHUNK = 64
MIX_WIDTH = MLA_WIDTH + GDN_WIDTH
D_FF = 4 * D_MODEL
EPS = 1e-6
IN_SPLITS = (Q_LORA_RANK, KV_LORA_RANK, QK_ROPE_DIM,
             GDN_WIDTH, GDN_WIDTH, GDN_WIDTH, GDN_WIDTH, GDN_HEADS, GDN_HEADS)
D_IN = sum(IN_SPLITS)

kernel_name = "hymba_mla_gdn_sqrelu_layer"


def rms_norm(x, w):
    xf = x.astype(jnp.float32)
    y = xf * lax.rsqrt(jnp.mean(xf * xf, axis=-1, keepdims=True) + EPS)
    return (y * w.astype(jnp.float32)).astype(x.dtype)


def l2_norm(x):
    return x * lax.rsqrt(jnp.sum(x * x, axis=-1, keepdims=True) + EPS)


def split_cols(t, sizes):
    offs = np.cumsum(sizes)[:-1].tolist()
    return jnp.split(t, offs, axis=-1)


def rope_angles(positions):
    half = QK_ROPE_DIM // 2
    inv_freq = ROPE_THETA ** (-jnp.arange(half, dtype=jnp.float32) / half)
    ang = positions.astype(jnp.float32)[..., None] * inv_freq
    return jnp.cos(ang)[:, :, None, :], jnp.sin(ang)[:, :, None, :]


def apply_rope(t, cos, sin):
    tf = t.astype(jnp.float32)
    t1, t2 = jnp.split(tf, 2, axis=-1)
    return jnp.concatenate([t1 * cos - t2 * sin, t2 * cos + t1 * sin], axis=-1).astype(t.dtype)


def causal_attention(q, k, v):
    B, S, H, _ = q.shape
    n_blocks = S // Q_BLOCK
    scale = QK_HEAD_DIM ** -0.5
    qb = jnp.moveaxis(q.reshape(B, n_blocks, Q_BLOCK, H, QK_HEAD_DIM), 1, 0)
    key_pos = jnp.arange(S)

    def one_block(args):
        q_blk, blk = args
        s = jnp.einsum('bqhd,bkhd->bhqk', q_blk, k,
                       preferred_element_type=jnp.float32) * scale
        q_pos = blk * Q_BLOCK + jnp.arange(Q_BLOCK)
        s = jnp.where(key_pos[None, :] <= q_pos[:, None], s, -jnp.inf)
        p = jax.nn.softmax(s, axis=-1).astype(v.dtype)
        return jnp.einsum('bhqk,bkhd->bqhd', p, v)

    o = lax.map(one_block, (qb, jnp.arange(n_blocks)))
    return jnp.moveaxis(o, 0, 1).reshape(B, S, H, V_HEAD_DIM)


def mla_group(q_lat, kv_lat, k_pe, cos, sin, q_lat_norm_w, w_uq, kv_lat_norm_w, w_ukv,
              q_norm_w, k_norm_w, mla_out_norm_w):
    B, S, _ = q_lat.shape
    q = (rms_norm(q_lat, q_lat_norm_w) @ w_uq).reshape(B, S, MLA_HEADS, QK_HEAD_DIM)
    kv = (rms_norm(kv_lat, kv_lat_norm_w) @ w_ukv).reshape(B, S, MLA_HEADS, QK_NOPE_DIM + V_HEAD_DIM)
    k_nope, v = jnp.split(kv, [QK_NOPE_DIM], axis=-1)
    q_nope = rms_norm(q[..., :QK_NOPE_DIM], q_norm_w[:QK_NOPE_DIM])
    q_pe = apply_rope(rms_norm(q[..., QK_NOPE_DIM:], q_norm_w[QK_NOPE_DIM:]), cos, sin)
    k_nope = rms_norm(k_nope, k_norm_w[:QK_NOPE_DIM])
    k_pe = apply_rope(rms_norm(k_pe[:, :, None, :], k_norm_w[QK_NOPE_DIM:]), cos, sin)
    q = jnp.concatenate([q_nope, q_pe], axis=-1)
    k = jnp.concatenate([k_nope, jnp.broadcast_to(k_pe, (B, S, MLA_HEADS, QK_ROPE_DIM))], axis=-1)
    o = causal_attention(q, k, v)
    o = rms_norm(o, mla_out_norm_w)
    return o.reshape(B, S, MLA_WIDTH)


def causal_conv(x, w):
    S = x.shape[1]
    xp = jnp.pad(x, ((0, 0), (CONV_WIDTH - 1, 0), (0, 0)))
    return sum(w[i] * xp[:, i:i + S] for i in range(CONV_WIDTH))


def chunk_gated_delta(q, k, v, g, beta):
    B, H, S, D = q.shape
    N = S // CHUNK
    q, k, v = [t.reshape(B, H, N, CHUNK, D) for t in (q, k, v)]
    g = g.reshape(B, H, N, CHUNK)
    beta = beta.reshape(B, H, N, CHUNK)
    G = jnp.cumsum(g, axis=-1)
    idx = jnp.arange(CHUNK)
    causal = idx[:, None] >= idx[None, :]
    strict = idx[:, None] > idx[None, :]
    decay = jnp.exp(jnp.where(causal, G[..., :, None] - G[..., None, :], -jnp.inf))
    kk = jnp.einsum('bhncd,bhnjd->bhncj', k, k)
    L = jnp.where(strict, beta[..., :, None] * kk * decay, 0.0)
    A = L + jnp.eye(CHUNK, dtype=L.dtype)
    rhs = jnp.concatenate([v * beta[..., None], k * (beta * jnp.exp(G))[..., None]], axis=-1)
    sol = lax.linalg.triangular_solve(A, rhs, left_side=True, lower=True, unit_diagonal=True)
    u, w = jnp.split(sol, 2, axis=-1)
    attn_intra = jnp.einsum('bhncd,bhnjd->bhncj', q, k) * decay
    q_dec = q * jnp.exp(G)[..., None]
    k_dec = k * jnp.exp(G[..., -1:] - G)[..., None]
    chunk_decay = jnp.exp(G[..., -1])

    def step(state, xs):
        u_c, w_c, a_c, qd_c, kd_c, cd_c = xs
        v_new = u_c - jnp.einsum('bhcd,bhde->bhce', w_c, state)
        o_c = jnp.einsum('bhcd,bhde->bhce', qd_c, state) + jnp.einsum('bhcj,bhje->bhce', a_c, v_new)
        state = state * cd_c[..., None, None] + jnp.einsum('bhcd,bhce->bhde', kd_c, v_new)
        return state, o_c

    xs = tuple(jnp.moveaxis(t, 2, 0) for t in (u, w, attn_intra, q_dec, k_dec, chunk_decay))
    state0 = jnp.zeros((B, H, D, D), jnp.float32)
    _, o = lax.scan(step, state0, xs)
    return jnp.moveaxis(o, 0, 2).reshape(B, H, S, D)


def gdn_group(q, k, v, z, a, b, conv_w, a_log, dt_bias, gdn_norm_w):
    B, S, _ = q.shape
    qkv = jax.nn.silu(causal_conv(jnp.concatenate([q, k, v], axis=-1), conv_w))
    q, k, v = [t.reshape(B, S, GDN_HEADS, GDN_HEAD_DIM).transpose(0, 2, 1, 3).astype(jnp.float32)
               for t in jnp.split(qkv, 3, axis=-1)]
    q = l2_norm(q) * (GDN_HEAD_DIM ** -0.5)
    k = l2_norm(k)
    beta = jax.nn.sigmoid(b.astype(jnp.float32)).transpose(0, 2, 1)
    g = (-jnp.exp(a_log.astype(jnp.float32))
         * jax.nn.softplus(a.astype(jnp.float32) + dt_bias.astype(jnp.float32))).transpose(0, 2, 1)
    o = chunk_gated_delta(q, k, v, g, beta).transpose(0, 2, 1, 3).astype(z.dtype)
    zh = z.reshape(B, S, GDN_HEADS, GDN_HEAD_DIM)
    o = rms_norm(o, gdn_norm_w) * jax.nn.silu(zh)
    return o.reshape(B, S, GDN_WIDTH)


def setup_inputs(seed: int = 0) -> dict:
    key = jax.random.key(seed)
    ks = jax.random.split(key, 20)
    L = DEPTH

    def normal(k, shape, fan_in):
        return jax.random.normal(k, shape, jnp.float32) * (fan_in ** -0.5)

    def gain(k, shape):
        return 1.0 + 0.02 * jax.random.normal(k, shape, jnp.float32)

    return {
        "x": jax.random.normal(ks[0], (BATCH, SEQ, D_MODEL), jnp.float32),
        "positions": jnp.broadcast_to(jnp.arange(SEQ, dtype=jnp.int32), (BATCH, SEQ)),
        "attn_norm_w": gain(ks[1], (L, D_MODEL)),
        "w_in": normal(ks[2], (L, D_MODEL, D_IN), D_MODEL),
        "q_lat_norm_w": gain(ks[3], (L, Q_LORA_RANK)),
        "w_uq": normal(ks[4], (L, Q_LORA_RANK, MLA_HEADS * QK_HEAD_DIM), Q_LORA_RANK),
        "kv_lat_norm_w": gain(ks[5], (L, KV_LORA_RANK)),
        "w_ukv": normal(ks[6], (L, KV_LORA_RANK, MLA_HEADS * (QK_NOPE_DIM + V_HEAD_DIM)), KV_LORA_RANK),
        "q_norm_w": gain(ks[7], (L, QK_HEAD_DIM)),
        "k_norm_w": gain(ks[8], (L, QK_HEAD_DIM)),
        "mla_out_norm_w": gain(ks[9], (L, MLA_HEADS, V_HEAD_DIM)),
        "conv_w": normal(ks[10], (L, CONV_WIDTH, 3 * GDN_WIDTH), CONV_WIDTH),
        "a_log": jnp.log(jax.random.uniform(ks[11], (L, GDN_HEADS), jnp.float32, 1.0, 16.0)),
        "dt_bias": 0.1 * jax.random.normal(ks[12], (L, GDN_HEADS), jnp.float32),
        "gdn_norm_w": gain(ks[13], (L, GDN_HEAD_DIM)),
        "w_out": normal(ks[14], (L, MIX_WIDTH, D_MODEL), MIX_WIDTH),
        "mlp_norm_w": gain(ks[15], (L, D_MODEL)),
        "w_up": normal(ks[16], (L, D_MODEL, D_FF), D_MODEL),
        "w_down": normal(ks[17], (L, D_FF, D_MODEL), D_FF),
    }


def reference(x, positions, attn_norm_w, w_in, q_lat_norm_w, w_uq, kv_lat_norm_w, w_ukv,
              q_norm_w, k_norm_w, mla_out_norm_w, conv_w, a_log, dt_bias, gdn_norm_w,
              w_out, mlp_norm_w, w_up, w_down):
    cos, sin = rope_angles(positions)
    h = x
    for l in range(DEPTH):
        xn = rms_norm(h, attn_norm_w[l])
        proj = xn @ w_in[l]
        q_lat, kv_lat, k_pe, gq, gk, gv, gz, ga, gb = split_cols(proj, IN_SPLITS)
        mla_o = mla_group(q_lat, kv_lat, k_pe, cos, sin, q_lat_norm_w[l], w_uq[l],
                          kv_lat_norm_w[l], w_ukv[l], q_norm_w[l], k_norm_w[l], mla_out_norm_w[l])
        gdn_o = gdn_group(gq, gk, gv, gz, ga, gb, conv_w[l], a_log[l], dt_bias[l], gdn_norm_w[l])
        h = h + jnp.concatenate([mla_o, gdn_o], axis=-1) @ w_out[l]
        hn = rms_norm(h, mlp_norm_w[l])
        h = h + jnp.square(jax.nn.relu(hn @ w_up[l])) @ w_down[l]
    return h
```

```cpp
#include <hip/hip_runtime.h>
#include <hip/hip_cooperative_groups.h>
#include <stdint.h>
#include <cstdio>
namespace cg = cooperative_groups;

typedef unsigned short bf16_t;
typedef short bf16x8 __attribute__((ext_vector_type(8)));
typedef float f32x4 __attribute__((ext_vector_type(4)));

constexpr int BATCH = 16, SEQ = 2048, DM = 1024, T = BATCH * SEQ, DFF = 4096;
constexpr int NPROJ = 2816, DIN = 2632;
constexpr int OFF_KVLAT = 256, OFF_KPE = 512, OFF_GQ = 576, OFF_GZ = 2112, OFF_GA = 2624;
constexpr float EPS = 1e-6f;
constexpr size_t MiB = 1u << 20;
constexpr size_t WS_WIN = 0, WS_WUQ = 6 * MiB, WS_WUKV = 6 * MiB + 512 * 1024, WS_WOUT = 7 * MiB, WS_WUP = 9 * MiB, WS_WDOWN = 17 * MiB;
constexpr size_t WS_SMALL = 25 * MiB;
constexpr size_t SM_SSQ_LAT = 0, SM_SSQ_QK = 256 * 1024, SM_SSQ_H = SM_SSQ_QK + 1536 * 1024, SM_QCTR = SM_SSQ_H + 128 * 1024, SM_ZERO_BYTES = SM_QCTR + 2048;
constexpr size_t WS_GAB = 28 * MiB, WS_GG = 29 * MiB, WS_GBETA = 29 * MiB + 512 * 1024;
constexpr size_t WS_PROJ = 32 * MiB;
constexpr size_t WS_XN = 208 * MiB, WS_QRAW = 208 * MiB, WS_KRAW = 256 * MiB, WS_MIX = 208 * MiB;
constexpr size_t WS_V = 288 * MiB, WS_Q = 320 * MiB, WS_K = 368 * MiB, WS_GQ = 416 * MiB, WS_GK = 448 * MiB, WS_GV = 480 * MiB;
constexpr size_t WS_HB = 288 * MiB, WS_ACT = 32 * MiB;

struct P {
    const float* x; const int* positions; const float* attn_norm_w; const float* w_in; const float* q_lat_norm_w; const float* w_uq;
    const float* kv_lat_norm_w; const float* w_ukv; const float* q_norm_w; const float* k_norm_w; const float* mla_out_norm_w;
    const float* conv_w; const float* a_log; const float* dt_bias; const float* gdn_norm_w; const float* w_out; const float* mlp_norm_w;
    const float* w_up; const float* w_down; float* out; unsigned char* ws;
};

__device__ __forceinline__ bf16_t f2bf(float f) { return __builtin_bit_cast(bf16_t, (__bf16)f); }
__device__ __forceinline__ float bf2f(bf16_t h) { return __builtin_bit_cast(float, (unsigned)h << 16); }
__device__ __forceinline__ float row16_sum(float s);
__device__ __forceinline__ float wave_sum(float v) { v = row16_sum(v); v += __shfl_xor(v, 16); v += __shfl_xor(v, 32); return v; }
__device__ __forceinline__ float row16_sum(float s) {
    s += __builtin_bit_cast(float, __builtin_amdgcn_mov_dpp(__builtin_bit_cast(int, s), 0xB1, 0xF, 0xF, true));
    s += __builtin_bit_cast(float, __builtin_amdgcn_mov_dpp(__builtin_bit_cast(int, s), 0x4E, 0xF, 0xF, true));
    s += __builtin_bit_cast(float, __builtin_amdgcn_mov_dpp(__builtin_bit_cast(int, s), 0x141, 0xF, 0xF, true));
    s += __builtin_bit_cast(float, __builtin_amdgcn_mov_dpp(__builtin_bit_cast(int, s), 0x140, 0xF, 0xF, true));
    return s;
}
__device__ __forceinline__ float wave_max(float v) {
#pragma unroll
    for (int o = 1; o < 64; o <<= 1) v = fmaxf(v, __shfl_xor(v, o));
    return v;
}
#define WSP(T_, off) ((T_*)(p.ws + (off)))
constexpr size_t WS_CD = 31 * MiB;
constexpr size_t WS_BAR = 31 * MiB + 65536, BAR_BYTES = 16384;
__device__ __forceinline__ int opq_v(int v) { asm volatile("" : "+v"(v)); return v; }
__device__ __forceinline__ int opq_s(int v) { asm volatile("" : "+s"(v)); return v; }

namespace pg8 {
#define PG8_LAS __attribute__((address_space(3)))
typedef unsigned short bf16_t;
typedef short bf16x8 __attribute__((ext_vector_type(8)));
typedef float f32x4 __attribute__((ext_vector_type(4)));
typedef unsigned u32x4 __attribute__((ext_vector_type(4)));
constexpr int BM = 256, BK = 64, HALF = 128, HTB = HALF * BK * 2  , STAGE_BYTES = 8 * HTB, NXCD = 8, WGM = 8;

__host__ __device__ __forceinline__ int lds_byte(int r, int c) { const int st = (r >> 4) * 2 + (c >> 5), rr = r & 15, cc = c & 31, ob = rr * 64 + cc * 2; return st * 1024 + (ob ^ (((ob >> 9) & 1) << 5)); }
__host__ __device__ __forceinline__ void stage_rc(int b, int& R, int& C) { const int st = b / 1024, sb = b % 1024, swz = sb ^ (((sb >> 9) & 1) << 5); R = (st >> 1) * 16 + swz / 64; C = (st & 1) * 32 + (swz % 64) / 2; }
__host__ __device__ __forceinline__ int perm32(int rho) { const int n = rho >> 4, i = rho & 15; return 8 * (i >> 2) + 4 * n + (i & 3); }

struct Unit { int pm, pn; };
struct Gemm { const bf16_t* A; const bf16_t* Bt; int M, N, K, lda, ldb; };

struct StaticOrder {
    int nM, nN, nwg, G, c;
    __host__ __device__ void init(int M, int N, int G_, int c_) { nM = M / BM; nN = N / BM; nwg = nM * nN; G = G_; c = c_; }
    __host__ __device__ bool next(int i, Unit& u) const {
        const long L = (long)i * G + c; if (L >= nwg) return false;
        int wgid = (int)L; { const int q = nwg / NXCD, r = nwg % NXCD, xcd = wgid % NXCD, off = wgid / NXCD; wgid = (xcd < r ? xcd * (q + 1) : r * (q + 1) + (xcd - r) * q) + off; }
        const int nig = WGM * nN, gid = wgid / nig, fm = gid * WGM, gsz = (nM - fm) < WGM ? (nM - fm) : WGM;
        u.pm = fm + ((wgid % nig) % gsz); u.pn = (wgid % nig) / gsz; return true;
    }
    __device__ __forceinline__ void a_ready(const Unit&) const {}
    __device__ __forceinline__ void done(const Unit&) const {}
};


__device__ __forceinline__ unsigned cvt_pk_bf16(float lo, float hi) { unsigned r; asm volatile("v_cvt_pk_bf16_f32 %0, %1, %2" : "=v"(r) : "v"(lo), "v"(hi)); return r; }
template <class Epi, class Sched, bool ALIGN_EPI = false, bool SP2 = false>
__device__ __forceinline__ void gemm_phase(PG8_LAS unsigned char* lds, const Gemm g, const Sched& S, const Epi& E) {
    const int tid = opq_v(threadIdx.x), wid = __builtin_amdgcn_readfirstlane(tid >> 6), lane = tid & 63, wr = wid >> 2, wc = wid & 3, fr = lane & 15, fq = lane >> 4;
    const int K = g.K, nt = K / BK;
    unsigned voffA[2], voffB[2];
#pragma unroll
    for (int i = 0; i < 2; ++i) { int R, C; stage_rc(tid * 16 + i * 8192, R, C); const int Rb = E.perm ? ((R & ~31) + perm32(R & 31)) : R;
        voffA[i] = (unsigned)(R * g.lda + C) * 2u; voffB[i] = (unsigned)(Rb * g.ldb + C) * 2u; }
    const size_t kstep = (size_t)(BK * 2);
    const size_t hstepA = (size_t)HALF * g.lda * 2, hstepB = (size_t)HALF * g.ldb * 2;
    const size_t tstepA = 2 * hstepA, tstepB = 2 * hstepB;
    const unsigned ldsw = (unsigned)wid * 1024u;
    const int aoff = lds_byte(wr * 64 + fr, fq * 8), boff = lds_byte(wc * 32 + fr, fq * 8);
#define PG8_SA(b, h) (((b) * 2 + (h)) * HTB)
#define PG8_SB(b, h) ((4 + (b) * 2 + (h)) * HTB)
#define PG8_STAGE(bufoff, gbase, voff) do { _Pragma("unroll") for (int _i = 0; _i < 2; ++_i) \
        __builtin_amdgcn_global_load_lds((const unsigned*)((const char*)(gbase) + (voff)[_i]), (PG8_LAS unsigned*)(lds + (bufoff) + ldsw + _i * 8192), 16, 0, 0); } while (0)
#define PG8_LDA(dst, b, h) do { _Pragma("unroll") for (int m = 0; m < 4; ++m) _Pragma("unroll") for (int k = 0; k < 2; ++k) dst[m][k] = *(const PG8_LAS bf16x8*)(lds + PG8_SA(b, h) + aoff + m * 2048 + k * 1024); } while (0)
#define PG8_LDB(dst, b, h) do { _Pragma("unroll") for (int n = 0; n < 2; ++n) _Pragma("unroll") for (int k = 0; k < 2; ++k) dst[n][k] = *(const PG8_LAS bf16x8*)(lds + PG8_SB(b, h) + boff + n * 2048 + k * 1024); } while (0)
#define PG8_MMA(ai, bj, At, Bt) do { __builtin_amdgcn_s_setprio(1); _Pragma("unroll") for (int m = 0; m < 4; ++m) _Pragma("unroll") for (int n = 0; n < 2; ++n) _Pragma("unroll") for (int k = 0; k < 2; ++k) \
        acc[ai][bj][m][n] = __builtin_amdgcn_mfma_f32_16x16x32_bf16(Bt[n][k], At[m][k], acc[ai][bj][m][n], 0, 0, 0); __builtin_amdgcn_s_setprio(0); } while (0)
#define PG8_WAIT_V(n) asm volatile("s_waitcnt vmcnt(" #n ")" ::: "memory")
#define PG8_WAIT_L(n) asm volatile("s_waitcnt lgkmcnt(" #n ")" ::: "memory")
#define PG8_BAR __builtin_amdgcn_s_barrier()
#define PG8_SCHED __builtin_amdgcn_sched_barrier(0)
    Unit cur, nxt; int ui = 0;
    if (!S.next(0, cur)) return;
    f32x4 acc[2][2][4][2];
#pragma unroll
    for (int a = 0; a < 2; ++a)
#pragma unroll
        for (int b = 0; b < 2; ++b)
#pragma unroll
            for (int m = 0; m < 4; ++m)
#pragma unroll
                for (int n = 0; n < 2; ++n) acc[a][b][m][n] = (f32x4){0.f, 0.f, 0.f, 0.f};
    bf16x8 At[4][2], B0[2][2], B1[2][2];
    const char* cA = (const char*)g.A + (size_t)cur.pm * tstepA; const char* cB = (const char*)g.Bt + (size_t)cur.pn * tstepB;
    S.a_ready(cur);
    if constexpr (SP2) {
        PG8_STAGE(PG8_SB(0, 0), cB, voffB); PG8_STAGE(PG8_SB(0, 1), cB + hstepB, voffB); PG8_STAGE(PG8_SA(0, 0), cA, voffA); PG8_STAGE(PG8_SA(0, 1), cA + hstepA, voffA);
        if (wr == 1) PG8_BAR;
        PG8_WAIT_V(2); PG8_BAR;
        PG8_STAGE(PG8_SB(1, 0), cB + kstep, voffB); PG8_STAGE(PG8_SA(1, 0), cA + kstep, voffA); PG8_STAGE(PG8_SB(1, 1), cB + hstepB + kstep, voffB);
        PG8_WAIT_V(6); PG8_BAR;
    } else {
        PG8_STAGE(PG8_SB(0, 0), cB, voffB); PG8_STAGE(PG8_SA(0, 0), cA, voffA); PG8_STAGE(PG8_SB(0, 1), cB + hstepB, voffB); PG8_STAGE(PG8_SA(0, 1), cA + hstepA, voffA);
        if (wr == 1) PG8_BAR;
        PG8_WAIT_V(4); PG8_BAR;
        PG8_STAGE(PG8_SB(1, 0), cB + kstep, voffB); PG8_STAGE(PG8_SA(1, 0), cA + kstep, voffA); PG8_STAGE(PG8_SB(1, 1), cB + hstepB + kstep, voffB);
        PG8_WAIT_V(6); PG8_BAR;
    }
    for (;;) {
        const bool has_next = S.next(ui + 1, nxt);
        const char* nA = has_next ? (const char*)g.A + (size_t)nxt.pm * tstepA : cA; const char* nB = has_next ? (const char*)g.Bt + (size_t)nxt.pn * tstepB : cB;
        for (int t = 0; t < nt; t += 2) {
            const bool last = (t == nt - 2);
            const char* a1 = cA + (size_t)(t + 1) * kstep;
            const char* a2 = last ? nA : cA + (size_t)(t + 2) * kstep; const char* b2 = last ? nB : cB + (size_t)(t + 2) * kstep;
            const char* a3 = a2 + kstep; const char* b3 = b2 + kstep;
            if (last && has_next) S.a_ready(nxt);
            if constexpr (SP2) {
            PG8_LDB(B0, 0, 0); PG8_LDB(B1, 0, 1); PG8_SCHED; PG8_LDA(At, 0, 0); PG8_STAGE(PG8_SA(1, 1), a1 + hstepA, voffA);
            PG8_WAIT_V(8); PG8_WAIT_L(0); PG8_BAR; PG8_MMA(0, 0, At, B0); PG8_MMA(0, 1, At, B1); PG8_BAR; PG8_SCHED;
            PG8_LDA(At, 0, 1); PG8_STAGE(PG8_SB(0, 0), b2, voffB); PG8_STAGE(PG8_SB(0, 1), b2 + hstepB, voffB); PG8_STAGE(PG8_SA(0, 0), a2, voffA);
            PG8_WAIT_V(8); PG8_WAIT_L(0); PG8_BAR; PG8_MMA(1, 0, At, B0); PG8_MMA(1, 1, At, B1); PG8_BAR; PG8_SCHED;
            PG8_LDB(B0, 1, 0); PG8_LDB(B1, 1, 1); PG8_SCHED; PG8_LDA(At, 1, 0); PG8_STAGE(PG8_SA(0, 1), a2 + hstepA, voffA);
            PG8_WAIT_V(8); PG8_WAIT_L(0); PG8_BAR; PG8_MMA(0, 0, At, B0); PG8_MMA(0, 1, At, B1); PG8_BAR; PG8_SCHED;
            PG8_LDA(At, 1, 1); PG8_STAGE(PG8_SB(1, 0), b3, voffB); PG8_STAGE(PG8_SB(1, 1), b3 + hstepB, voffB); PG8_STAGE(PG8_SA(1, 0), a3, voffA);
            PG8_WAIT_V(8); PG8_WAIT_L(0); PG8_BAR; PG8_MMA(1, 0, At, B0); PG8_MMA(1, 1, At, B1); PG8_BAR; PG8_SCHED;
            } else {
            PG8_LDB(B0, 0, 0); PG8_SCHED; PG8_LDA(At, 0, 0); PG8_STAGE(PG8_SA(1, 1), a1 + hstepA, voffA);
            PG8_WAIT_L(8); PG8_BAR; PG8_WAIT_L(0); PG8_MMA(0, 0, At, B0); PG8_BAR; PG8_SCHED;
            PG8_LDB(B1, 0, 1); PG8_STAGE(PG8_SB(0, 0), b2, voffB);
            PG8_BAR; PG8_WAIT_L(0); PG8_MMA(0, 1, At, B1); PG8_BAR;
            PG8_LDA(At, 0, 1); PG8_STAGE(PG8_SA(0, 0), a2, voffA);
            PG8_BAR; PG8_WAIT_L(0); PG8_MMA(1, 0, At, B0); PG8_BAR; PG8_SCHED;
            PG8_STAGE(PG8_SB(0, 1), b2 + hstepB, voffB);
            PG8_WAIT_V(6); PG8_BAR; PG8_MMA(1, 1, At, B1); PG8_BAR;
            PG8_LDB(B0, 1, 0); PG8_SCHED; PG8_LDA(At, 1, 0); PG8_STAGE(PG8_SA(0, 1), a2 + hstepA, voffA);
            PG8_WAIT_L(8); PG8_BAR; PG8_WAIT_L(0); PG8_MMA(0, 0, At, B0); PG8_BAR; PG8_SCHED;
            PG8_LDB(B1, 1, 1); PG8_STAGE(PG8_SB(1, 0), b3, voffB);
            PG8_BAR; PG8_WAIT_L(0); PG8_MMA(0, 1, At, B1); PG8_BAR;
            PG8_LDA(At, 1, 1); PG8_STAGE(PG8_SA(1, 0), a3, voffA);
            PG8_BAR; PG8_WAIT_L(0); PG8_MMA(1, 0, At, B0); PG8_BAR; PG8_SCHED;
            PG8_STAGE(PG8_SB(1, 1), b3 + hstepB, voffB);
            PG8_WAIT_V(6); PG8_BAR; PG8_MMA(1, 1, At, B1); PG8_BAR;
            }
        }
        if constexpr (ALIGN_EPI) { if (wr == 0) PG8_BAR; }
        if constexpr (!Epi::AFTER_DRAIN) { E(acc, cur, wr, wc, fr, fq); S.done(cur); }
        if (!has_next) break;
#pragma unroll
        for (int a = 0; a < 2; ++a)
#pragma unroll
            for (int b = 0; b < 2; ++b)
#pragma unroll
                for (int m = 0; m < 4; ++m)
#pragma unroll
                    for (int n = 0; n < 2; ++n) acc[a][b][m][n] = (f32x4){0.f, 0.f, 0.f, 0.f};
        cur = nxt; cA = nA; cB = nB; ++ui;
        if constexpr (ALIGN_EPI) { if (wr == 1) PG8_BAR; }
    }
    PG8_WAIT_V(0);
    if constexpr (!ALIGN_EPI) { if (wr == 0) PG8_BAR; }
    PG8_BAR;
    if constexpr (Epi::AFTER_DRAIN) { E.fused(acc, cur, wr, wc, fr, fq, lds, wid, lane); S.done(cur); }
#undef PG8_SA
#undef PG8_SB
#undef PG8_STAGE
#undef PG8_LDA
#undef PG8_LDB
#undef PG8_MMA
#undef PG8_WAIT_V
#undef PG8_WAIT_L
#undef PG8_BAR
#undef PG8_SCHED
}

}
using pg8::Unit; using pg8::cvt_pk_bf16;
typedef unsigned u32x4 __attribute__((ext_vector_type(4)));
typedef unsigned u32x2 __attribute__((ext_vector_type(2)));
__device__ __forceinline__ float quad_sum(float s) { s += __shfl_xor(s, 16); s += __shfl_xor(s, 32); return s; }
__device__ __forceinline__ u32x4 pack8bf(f32x4 a, f32x4 b) { u32x4 w; w.x = cvt_pk_bf16(a[0], a[1]); w.y = cvt_pk_bf16(a[2], a[3]); w.z = cvt_pk_bf16(b[0], b[1]); w.w = cvt_pk_bf16(b[2], b[3]); return w; }
__device__ __forceinline__ float sq8(f32x4 a, f32x4 b) { return (a[0] * a[0] + a[1] * a[1]) + (a[2] * a[2] + a[3] * a[3]) + (b[0] * b[0] + b[1] * b[1]) + (b[2] * b[2] + b[3] * b[3]); }
#define EPI_ARGS const f32x4 (&acc)[2][2][4][2], const Unit& u, int wr, int wc, int fr, int fq
#define EPI_ROWS _Pragma("unroll") for (int ai = 0; ai < 2; ++ai) _Pragma("unroll") for (int m = 0; m < 4; ++m)

struct GEpiProj { static constexpr bool PERM = true, AFTER_DRAIN = false; bf16_t* proj; float* ssq_lat; float* gab;
    __device__ __forceinline__ void operator()(EPI_ARGS) const {
        const int row0 = u.pm * 256 + wr * 64 + fr, col0 = u.pn * 256 + wc * 32 + 8 * fq;
        EPI_ROWS { const int row = row0 + ai * 128 + m * 16; bf16_t* rowp = proj + (size_t)row * NPROJ + col0; float s = 0.f;
#pragma unroll
            for (int bj = 0; bj < 2; ++bj) { const f32x4 v0 = acc[ai][bj][m][0], v1 = acc[ai][bj][m][1]; *(u32x4*)(rowp + bj * 128) = pack8bf(v0, v1); s += sq8(v0, v1);
                if (bj == 0 && u.pn == 10 && wc == 2 && fq == 0) { *(f32x4*)(gab + (size_t)row * 8) = v0; *(f32x4*)(gab + (size_t)row * 8 + 4) = v1; } }
            if (u.pn < 2) { s = quad_sum(s); if (fq == 0) unsafeAtomicAdd(&ssq_lat[row * 2 + u.pn], s); } }
    } };
struct GEpiQ { static constexpr bool PERM = true, AFTER_DRAIN = false; const float* ssq_lat; bf16_t* qraw; float* ssq_qk;
    __device__ __forceinline__ void operator()(EPI_ARGS) const {
        const int row0 = u.pm * 256 + wr * 64 + fr, col0 = u.pn * 256 + wc * 32 + 8 * fq;
        EPI_ROWS { const int row = row0 + ai * 128 + m * 16; const float rs = __builtin_amdgcn_rsqf(ssq_lat[row * 2] * (1.f / 256) + EPS); bf16_t* rowp = qraw + (size_t)row * 768 + col0;
#pragma unroll
            for (int bj = 0; bj < 2; ++bj) { const f32x4 v0 = acc[ai][bj][m][0] * rs, v1 = acc[ai][bj][m][1] * rs; *(u32x4*)(rowp + bj * 128) = pack8bf(v0, v1);
            } }
    } };
struct GEpiKV { static constexpr bool PERM = true, AFTER_DRAIN = false; const float* ssq_lat; bf16_t* kraw; bf16_t* V; float* ssq_qk;
    __device__ __forceinline__ void operator()(EPI_ARGS) const {
        const int row0 = u.pm * 256 + wr * 64 + fr, h = u.pn, cw = wc * 32 + 8 * fq;
        EPI_ROWS { const int row = row0 + ai * 128 + m * 16; const float rs = __builtin_amdgcn_rsqf(ssq_lat[row * 2 + 1] * (1.f / 256) + EPS);
            { const f32x4 v0 = acc[ai][0][m][0] * rs, v1 = acc[ai][0][m][1] * rs; *(u32x4*)(kraw + (size_t)row * 512 + h * 128 + cw) = pack8bf(v0, v1);
            }
            { const f32x4 v0 = acc[ai][1][m][0] * rs, v1 = acc[ai][1][m][1] * rs; const int b = row / SEQ, s = row % SEQ;
              *(u32x4*)(V + ((size_t)(b * 4 + h) * SEQ + s) * 128 + cw) = pack8bf(v0, v1); } }
    } };
struct GEpiOut { static constexpr bool PERM = false, AFTER_DRAIN = false; const float* x; float* out; bf16_t* hb; float* ssq_h;
    __device__ __forceinline__ void operator()(EPI_ARGS) const {
        const int row0 = u.pm * 256 + wr * 64 + fr, col0 = u.pn * 256 + wc * 32 + 4 * fq;
        EPI_ROWS { const int row = row0 + ai * 128 + m * 16; const size_t off = (size_t)row * DM + col0; float s = 0.f;
#pragma unroll
            for (int bj = 0; bj < 2; ++bj)
#pragma unroll
                for (int n = 0; n < 2; ++n) { const size_t o = off + bj * 128 + n * 16; const f32x4 hv = *(const f32x4*)(x + o) + acc[ai][bj][m][n];
                    u32x2 w; w.x = cvt_pk_bf16(hv[0], hv[1]); w.y = cvt_pk_bf16(hv[2], hv[3]); *(u32x2*)(hb + o) = w; s += (hv[0] * hv[0] + hv[1] * hv[1]) + (hv[2] * hv[2] + hv[3] * hv[3]); }
            s = quad_sum(s); if (fq == 0) unsafeAtomicAdd(&ssq_h[row], s); }
    } };
struct GEpiUp { static constexpr bool PERM = true, AFTER_DRAIN = false; const float* ssq_h; bf16_t* act;
    __device__ __forceinline__ void operator()(EPI_ARGS) const {
        const int row0 = u.pm * 256 + wr * 64 + fr, col0 = u.pn * 256 + wc * 32 + 8 * fq;
        EPI_ROWS { const int row = row0 + ai * 128 + m * 16; const float rs = __builtin_amdgcn_rsqf(ssq_h[row] * (1.f / DM) + EPS); bf16_t* rowp = act + (size_t)row * DFF + col0;
#pragma unroll
            for (int bj = 0; bj < 2; ++bj) { f32x4 v0 = acc[ai][bj][m][0] * rs, v1 = acc[ai][bj][m][1] * rs;
#pragma unroll
                for (int r = 0; r < 4; ++r) { const float a = fmaxf(v0[r], 0.f), b = fmaxf(v1[r], 0.f); v0[r] = a * a; v1[r] = b * b; }
                *(u32x4*)(rowp + bj * 128) = pack8bf(v0, v1); } }
    } };
struct GEpiDown { static constexpr bool PERM = false, AFTER_DRAIN = false; float* out; const bf16_t* hb;
    __device__ __forceinline__ void operator()(EPI_ARGS) const {
        const int row0 = u.pm * 256 + wr * 64 + fr, col0 = u.pn * 256 + wc * 32 + 4 * fq;
        EPI_ROWS { const int row = row0 + ai * 128 + m * 16; const size_t off = (size_t)row * DM + col0;
#pragma unroll
            for (int bj = 0; bj < 2; ++bj)
#pragma unroll
                for (int n = 0; n < 2; ++n) { const size_t o = off + bj * 128 + n * 16; const u32x2 hw = *(const u32x2*)(hb + o);
                    const f32x4 hv = {__builtin_bit_cast(float, hw.x << 16), __builtin_bit_cast(float, hw.x & 0xffff0000u), __builtin_bit_cast(float, hw.y << 16), __builtin_bit_cast(float, hw.y & 0xffff0000u)};
                    *(f32x4*)(out + o) = hv + acc[ai][bj][m][n]; } }
    } };
struct GEpi { static constexpr bool AFTER_DRAIN = false; int kind; bool perm; unsigned char* ws; const float* x; float* out;
    __device__ __forceinline__ void operator()(EPI_ARGS) const {
        float* ssq_lat = (float*)(ws + WS_SMALL + SM_SSQ_LAT); float* ssq_qk = (float*)(ws + WS_SMALL + SM_SSQ_QK); float* ssq_h = (float*)(ws + WS_SMALL + SM_SSQ_H);
        switch (kind) {
        case 0: GEpiProj{(bf16_t*)(ws + WS_PROJ), ssq_lat, (float*)(ws + WS_GAB)}(acc, u, wr, wc, fr, fq); break;
        case 1: GEpiQ{ssq_lat, (bf16_t*)(ws + WS_QRAW), ssq_qk}(acc, u, wr, wc, fr, fq); break;
        case 2: GEpiKV{ssq_lat, (bf16_t*)(ws + WS_KRAW), (bf16_t*)(ws + WS_V), ssq_qk}(acc, u, wr, wc, fr, fq); break;
        case 3: GEpiOut{x, out, (bf16_t*)(ws + WS_HB), ssq_h}(acc, u, wr, wc, fr, fq); break;
        case 4: GEpiUp{ssq_h, (bf16_t*)(ws + WS_ACT)}(acc, u, wr, wc, fr, fq); break;
        default: GEpiDown{out, (const bf16_t*)(ws + WS_HB)}(acc, u, wr, wc, fr, fq); break;
        }
    } };

__device__ __forceinline__ int uq_orig_col(int n) { if (n < 512) return (n >> 7) * 192 + (n & 127); const int r = n - 512; return (r >> 6) * 192 + 128 + (r & 63); }
__device__ __forceinline__ void wt_item(const float* W, int K, int N, bf16_t* WT, const float* ksc, int perm, __attribute__((address_space(3))) float* scr, int item, int lane, int nblk) {
    const int kb = item / nblk, nb = item - kb * nblk, k0 = 64 * kb, np0 = 64 * nb; const int n0 = perm ? uq_orig_col(np0) : np0;
    const int rsub = lane >> 4, c4 = (lane & 15) * 4; const bool ok = n0 + c4 < N;
#pragma unroll
    for (int i = 0; i < 16; ++i) { const int kk = 4 * i + rsub; f32x4 v = ok ? *(const f32x4*)(W + (size_t)(k0 + kk) * N + n0 + c4) : (f32x4){0.f, 0.f, 0.f, 0.f}; if (ksc) v = v * ksc[k0 + kk];
        scr[kk * 65 + c4] = v.x; scr[kk * 65 + c4 + 1] = v.y; scr[kk * 65 + c4 + 2] = v.z; scr[kk * 65 + c4 + 3] = v.w; }
    const int c = lane & 7;
#pragma unroll
    for (int j = 0; j < 8; ++j) { const int nn = (lane >> 3) + 8 * j; const __attribute__((address_space(3))) float* s = scr + (8 * c) * 65 + nn;
        u32x4 o; o.x = cvt_pk_bf16(s[0 * 65], s[1 * 65]); o.y = cvt_pk_bf16(s[2 * 65], s[3 * 65]); o.z = cvt_pk_bf16(s[4 * 65], s[5 * 65]); o.w = cvt_pk_bf16(s[6 * 65], s[7 * 65]);
        *(u32x4*)(WT + (size_t)(np0 + nn) * K + k0 + 8 * c) = o; }
}
constexpr int WI0 = (DM / 64) * (NPROJ / 64), WI1 = (256 / 64) * (768 / 64), WI2 = (256 / 64) * (1024 / 64), WI3 = (DM / 64) * (DM / 64), WI4 = (DM / 64) * (DFF / 64), WI5 = (DFF / 64) * (DM / 64);
__device__ __forceinline__ void wt_range(const P& p, unsigned char* lds, int lo, int hi, int gw0, int nwv) {
    const int tix = opq_v(threadIdx.x); const int lane = tix & 63, wv = __builtin_amdgcn_readfirstlane(tix >> 6);
    __attribute__((address_space(3))) float* scr = (__attribute__((address_space(3))) float*)((__attribute__((address_space(3))) unsigned char*)lds + wv * 16640);
#pragma clang loop unroll(disable)
    for (int it = lo + gw0 + wv; it < hi; it += nwv) {
        int r = it; const float* W; const float* ksc = nullptr; bf16_t* WT; int K, N, nblk, perm = 0;
        if (r < WI0) { W = p.w_in; K = DM; N = DIN; nblk = NPROJ / 64; WT = WSP(bf16_t, WS_WIN); }
        else if ((r -= WI0) < WI1) { W = p.w_uq; K = 256; N = 768; nblk = 768 / 64; WT = WSP(bf16_t, WS_WUQ); ksc = p.q_lat_norm_w; perm = 1; }
        else if ((r -= WI1) < WI2) { W = p.w_ukv; K = 256; N = 1024; nblk = 1024 / 64; WT = WSP(bf16_t, WS_WUKV); ksc = p.kv_lat_norm_w; }
        else if ((r -= WI2) < WI3) { W = p.w_out; K = DM; N = DM; nblk = DM / 64; WT = WSP(bf16_t, WS_WOUT); }
        else if ((r -= WI3) < WI4) { W = p.w_up; K = DM; N = DFF; nblk = DFF / 64; WT = WSP(bf16_t, WS_WUP); ksc = p.mlp_norm_w; }
        else { r -= WI4; W = p.w_down; K = DFF; N = DM; nblk = DM / 64; WT = WSP(bf16_t, WS_WDOWN); }
        wt_item(W, K, N, WT, ksc, perm, scr, r, lane, nblk);
    }
}
__device__ __forceinline__ void ph_prologue(const P& p, unsigned char* lds) {
    const int tix = opq_v(threadIdx.x), bix = opq_s(blockIdx.x);
    const size_t gt = (size_t)bix * 512 + tix, gn = (size_t)gridDim.x * 512;
    for (size_t i = gt; i < SM_SSQ_QK / 4; i += gn) WSP(float, WS_SMALL)[i] = 0.f;
    for (size_t i = SM_SSQ_H / 4 + gt; i < SM_ZERO_BYTES / 4; i += gn) WSP(float, WS_SMALL)[i] = 0.f;
    const int lane = tix & 63, wv = __builtin_amdgcn_readfirstlane(tix >> 6), gw = bix * 8 + wv, nw = gridDim.x * 8;
    const bool defer = (gridDim.x == 256);
    wt_range(p, lds, 0, defer ? WI0 + WI1 + WI2 : WI0 + WI1 + WI2 + WI3 + WI4 + WI5, bix * 8, nw);

    bf16_t* XN = WSP(bf16_t, WS_XN);
    {
        f32x4 wv4[4], v[4], vn[4];
#pragma unroll
        for (int j = 0; j < 4; ++j) wv4[j] = ((const f32x4*)p.attn_norm_w)[lane + 64 * j];
        int m = gw;
        if (m < T) {
#pragma unroll
            for (int j = 0; j < 4; ++j) v[j] = ((const f32x4*)(p.x + (size_t)m * DM))[lane + 64 * j]; }
        for (; m < T; m += nw) {
            const int mn = m + nw < T ? m + nw : m;
#pragma unroll
            for (int j = 0; j < 4; ++j) vn[j] = ((const f32x4*)(p.x + (size_t)mn * DM))[lane + 64 * j];
            float s = 0.f;
#pragma unroll
            for (int j = 0; j < 4; ++j) s += v[j].x * v[j].x + v[j].y * v[j].y + v[j].z * v[j].z + v[j].w * v[j].w;
            const float rs = __builtin_amdgcn_rsqf(wave_sum(s) * (1.f / DM) + EPS);
#pragma unroll
            for (int j = 0; j < 4; ++j) { const f32x4 w = wv4[j]; const int c = (lane + 64 * j) * 4;
                u32x2 o; o.x = cvt_pk_bf16(v[j].x * rs * w.x, v[j].y * rs * w.y); o.y = cvt_pk_bf16(v[j].z * rs * w.z, v[j].w * rs * w.w);
                *(u32x2*)(XN + (size_t)m * DM + c) = o; v[j] = vn[j]; }
        }
    }
}
__device__ __forceinline__ void bf8_to_f(bf16x8 x, float* f) {
#pragma unroll
    for (int t = 0; t < 8; ++t) f[t] = bf2f((bf16_t)x[t]);
}
__device__ __forceinline__ void ph_qk_finalize(const P& p) {
    const int tix = opq_v(threadIdx.x), bix = opq_s(blockIdx.x);
    const int lane = tix & 63, gw = bix * 8 + (tix >> 6), nw = gridDim.x * 8;
    const bf16_t* QRAW = WSP(bf16_t, WS_QRAW); const bf16_t* KRAW = WSP(bf16_t, WS_KRAW); const bf16_t* PROJ = WSP(bf16_t, WS_PROJ);
    const float* ssq = WSP(float, WS_SMALL + SM_SSQ_QK); bf16_t* Q = WSP(bf16_t, WS_Q); bf16_t* Kc = WSP(bf16_t, WS_K);
    const int d8 = (lane & 15) * 8, hq = lane >> 4, hh = lane >> 5, j = lane & 31;
    float wq[8], wk[8];
#pragma unroll
    for (int t = 0; t < 8; ++t) { wq[t] = p.q_norm_w[d8 + t]; wk[t] = p.k_norm_w[d8 + t]; }
    const float wq1 = p.q_norm_w[128 + j], wq2 = p.q_norm_w[160 + j], wk1 = p.k_norm_w[128 + j], wk2 = p.k_norm_w[160 + j];
    const float invf = exp2f(-(float)j * (1.f / 32) * 13.287712379549449f);
    bf16x8 qv, kv, nqv, nkv; float s0 = 0, s1 = 0, s2 = 0, s3 = 0, ns0 = 0, ns1 = 0, ns2 = 0, ns3 = 0; bf16_t e0, e1, e2, e3, e4, e5, ne0, ne1, ne2, ne3, ne4, ne5; int ps, nps;
#define QKF_LOAD(M, QV, KV, S0, S1, S2, S3, E0, E1, E2, E3, E4, E5, PS) do { QV = *(const bf16x8*)(QRAW + (size_t)(M) * 768 + lane * 8); KV = *(const bf16x8*)(KRAW + (size_t)(M) * 512 + lane * 8); \
        const bf16_t* qr_ = QRAW + (size_t)(M) * 768 + 512 + hh * 128; const bf16_t* kr_ = PROJ + (size_t)(M) * NPROJ + OFF_KPE; \
        E0 = qr_[j]; E1 = qr_[32 + j]; E2 = qr_[64 + j]; E3 = qr_[96 + j]; E4 = kr_[j]; E5 = kr_[32 + j]; PS = p.positions[M]; } while (0)
    int m = gw;
    if (m < T) QKF_LOAD(m, qv, kv, s0, s1, s2, s3, e0, e1, e2, e3, e4, e5, ps);
#pragma unroll 2
    for (; m < T; m += nw) {
        const int mn = m + nw < T ? m + nw : m;
        QKF_LOAD(mn, nqv, nkv, ns0, ns1, ns2, ns3, ne0, ne1, ne2, ne3, ne4, ne5, nps);
        const int b = m / SEQ, s = m % SEQ;
        float fq8[8], fk8[8]; bf8_to_f(qv, fq8); bf8_to_f(kv, fk8);
        float sqn = 0.f, skn = 0.f;
#pragma unroll
        for (int t = 0; t < 8; ++t) { sqn += fq8[t] * fq8[t]; skn += fk8[t] * fk8[t]; }
        sqn = row16_sum(sqn); skn = row16_sum(skn);
        const float rq = __builtin_amdgcn_rsqf(sqn * (1.f / 128) + EPS), rk = __builtin_amdgcn_rsqf(skn * (1.f / 128) + EPS);
        const float a1 = bf2f(e0), a2 = bf2f(e1), b1 = bf2f(e2), b2 = bf2f(e3); float k1 = bf2f(e4), k2 = bf2f(e5);
        float sra = row16_sum(a1 * a1 + a2 * a2), srb = row16_sum(b1 * b1 + b2 * b2); sra += __shfl_xor(sra, 16); srb += __shfl_xor(srb, 16);
        const float ra = __builtin_amdgcn_rsqf(sra * (1.f / 64) + EPS), rb = __builtin_amdgcn_rsqf(srb * (1.f / 64) + EPS);
        const float ang = (float)ps * invf; float rev = ang * 0.15915494309189535f; rev -= floorf(rev);
        const float c = __builtin_amdgcn_cosf(rev), sn = __builtin_amdgcn_sinf(rev);
        float f[8]; const size_t o = ((size_t)(b * 4 + hq) * SEQ + s) * 192 + d8;
        for (int t = 0; t < 8; ++t) f[t] = fq8[t]; { u32x4 w; w.x = cvt_pk_bf16(f[0] * rq * wq[0], f[1] * rq * wq[1]); w.y = cvt_pk_bf16(f[2] * rq * wq[2], f[3] * rq * wq[3]); w.z = cvt_pk_bf16(f[4] * rq * wq[4], f[5] * rq * wq[5]); w.w = cvt_pk_bf16(f[6] * rq * wq[6], f[7] * rq * wq[7]); *(u32x4*)(Q + o) = w; }
        for (int t = 0; t < 8; ++t) f[t] = fk8[t]; { u32x4 w; w.x = cvt_pk_bf16(f[0] * rk * wk[0], f[1] * rk * wk[1]); w.y = cvt_pk_bf16(f[2] * rk * wk[2], f[3] * rk * wk[3]); w.z = cvt_pk_bf16(f[4] * rk * wk[4], f[5] * rk * wk[5]); w.w = cvt_pk_bf16(f[6] * rk * wk[6], f[7] * rk * wk[7]); *(u32x4*)(Kc + o) = w; }
        const float kss = wave_sum(k1 * k1 + k2 * k2) * 0.5f; const float rkk = __builtin_amdgcn_rsqf(kss * (1.f / 64) + EPS);
        k1 *= rkk * wk1; k2 *= rkk * wk2; const bf16_t ko1 = f2bf(k1 * c - k2 * sn), ko2 = f2bf(k2 * c + k1 * sn);
        const float p1 = a1 * ra * wq1, p2 = a2 * ra * wq2, r1 = b1 * rb * wq1, r2 = b2 * rb * wq2;
        const size_t o0 = ((size_t)(b * 4 + hh * 2) * SEQ + s) * 192 + 128, o1 = o0 + (size_t)SEQ * 192;
        Q[o0 + j] = f2bf(p1 * c - p2 * sn); Q[o0 + 32 + j] = f2bf(p2 * c + p1 * sn); Q[o1 + j] = f2bf(r1 * c - r2 * sn); Q[o1 + 32 + j] = f2bf(r2 * c + r1 * sn);
        Kc[o0 + j] = ko1; Kc[o0 + 32 + j] = ko2; Kc[o1 + j] = ko1; Kc[o1 + 32 + j] = ko2;
        qv = nqv; kv = nkv; e0 = ne0; e1 = ne1; e2 = ne2; e3 = ne3; e4 = ne4; e5 = ne5; ps = nps;
    }
#undef QKF_LOAD
}
__device__ __forceinline__ void ph_gdn_prep(const P& p) {
    const int tix = opq_v(threadIdx.x), bix = opq_s(blockIdx.x);
    const int lane = tix & 63, gw = bix * 8 + (tix >> 6), nw = gridDim.x * 8;
    const bf16_t* PROJ = WSP(bf16_t, WS_PROJ); const float* gab = WSP(float, WS_GAB);
    const int part = (lane >> 4) < 3 ? (lane >> 4) : 2, c8 = (lane & 15) * 8; const bool live = lane < 48;
    bf16_t* dstb = part == 0 ? WSP(bf16_t, WS_GQ) : (part == 1 ? WSP(bf16_t, WS_GK) : WSP(bf16_t, WS_GV));
#pragma clang loop unroll(disable)
    for (int item = gw; item < BATCH * 4 * 32; item += nw) {
        const int bh = item >> 5, run = item & 31, b = bh >> 2, h = bh & 3, s0 = run * 64; const int cw = part * 512 + h * 128 + c8;
        float w[4][8];
#pragma unroll
        for (int i = 0; i < 4; ++i)
#pragma unroll
            for (int t = 0; t < 8; ++t) w[i][t] = p.conv_w[i * 1536 + cw + t];
        const bf16_t* src = PROJ + ((size_t)b * SEQ + s0) * NPROJ + OFF_GQ + cw; bf16_t* dst = dstb + ((size_t)bh * SEQ + s0) * 128 + c8;
        float x1[8], x2[8], x3[8];
        if (s0 > 0) { bf8_to_f(*(const bf16x8*)(src - 3 * (size_t)NPROJ), x1); bf8_to_f(*(const bf16x8*)(src - 2 * (size_t)NPROJ), x2); bf8_to_f(*(const bf16x8*)(src - (size_t)NPROJ), x3); }
        else {
#pragma unroll
            for (int t = 0; t < 8; ++t) { x1[t] = 0.f; x2[t] = 0.f; x3[t] = 0.f; } }
        bf16x8 cur[8], nxt[8];
#pragma unroll
        for (int t = 0; t < 8; ++t) cur[t] = *(const bf16x8*)(src + (size_t)t * NPROJ);
#pragma clang loop unroll(disable)
        for (int sb = 0; sb < 8; ++sb) {
            if (sb < 7) {
#pragma unroll
                for (int t = 0; t < 8; ++t) nxt[t] = *(const bf16x8*)(src + (size_t)((sb + 1) * 8 + t) * NPROJ); }
#pragma unroll
            for (int u = 0; u < 8; ++u) {
                float x0[8]; bf8_to_f(cur[u], x0);
                float y[8], ss = 0.f;
#pragma unroll
                for (int t = 0; t < 8; ++t) { const float a = w[0][t] * x1[t] + w[1][t] * x2[t] + w[2][t] * x3[t] + w[3][t] * x0[t]; y[t] = a * __builtin_amdgcn_rcpf(1.f + __expf(-a)); ss += y[t] * y[t]; x1[t] = x2[t]; x2[t] = x3[t]; x3[t] = x0[t]; }
                ss = row16_sum(ss);
                const float sc = part == 0 ? __builtin_amdgcn_rsqf(ss + EPS) * 0.08838834764831845f : (part == 1 ? __builtin_amdgcn_rsqf(ss + EPS) : 1.f);
                u32x4 o; o.x = cvt_pk_bf16(y[0] * sc, y[1] * sc); o.y = cvt_pk_bf16(y[2] * sc, y[3] * sc); o.z = cvt_pk_bf16(y[4] * sc, y[5] * sc); o.w = cvt_pk_bf16(y[6] * sc, y[7] * sc);
                if (live) *(u32x4*)(dst + (size_t)(sb * 8 + u) * 128) = o;
            }
#pragma unroll
            for (int t = 0; t < 8; ++t) cur[t] = nxt[t];
        }
    }
    for (int idx = bix * 512 + tix; idx < T * 4; idx += (int)gridDim.x * 512) { const int m = idx >> 2, h = idx & 3, b = m / SEQ, s = m % SEQ;
        const float a = gab[m * 8 + h] + p.dt_bias[h]; const float sp = a > 20.f ? a : __logf(1.f + __expf(a));
        WSP(float, WS_GG)[(size_t)(b * 4 + h) * SEQ + s] = -__expf(p.a_log[h]) * sp;
        WSP(float, WS_GBETA)[(size_t)(b * 4 + h) * SEQ + s] = 1.f / (1.f + __expf(-gab[m * 8 + 4 + h])); }
}
namespace att {
#define LAS __attribute__((address_space(3)))
typedef float f32x16 __attribute__((ext_vector_type(16)));
typedef short s16x4 __attribute__((ext_vector_type(4)));
constexpr int KVBLK = 64, QBLK = 32, QB = 256;
constexpr int SHM_V = 64 * 128 * 2, SHM_K = 64 * 192 * 2, OFF_K = 2 * SHM_V, OFF_WS = OFF_K + 2 * SHM_K;
constexpr float SCALE = 0.07216878364870323f, THR = 8.f;
constexpr int NQR = 6, OFF_QS = OFF_WS + 8 * 64 * 4;
#define KSWZ(row, colB) ((row) * 384 + ((colB) ^ ((((row) >> 1) & 7) << 4)))
#define SBAR() __builtin_amdgcn_sched_barrier(0)
__device__ __forceinline__ int v_st(int k, int c) { const int kk = (k & ~0xC) | ((k & 4) << 1) | ((k & 8) >> 1); return ((kk >> 3) * 4 + (c >> 5)) * 512 + ((kk & 7) * 32 + (c & 31)) * 2; }
__device__ __forceinline__ int v_rd_base(int lane) { return ((lane & 3) << 3) | (((lane >> 2) & 3) << 6) | (((lane >> 4) & 1) << 5) | (((lane >> 5) & 1) << 8); }
constexpr int v_rd_off(int d0, int ks, int half) { return d0 * 512 + ks * 4096 + half * 2048; }
__device__ __forceinline__ int crow(int r, int hi) { return (r & 3) + 8 * (r >> 2) + 4 * hi; }
__device__ __forceinline__ unsigned cvtpk(float lo, float hi) { unsigned r; asm volatile("v_cvt_pk_bf16_f32 %0, %1, %2" : "=v"(r) : "v"(lo), "v"(hi)); return r; }
__device__ __forceinline__ void mask_tile(f32x16& p0, f32x16& p1, int dq) {
    const float NEG = -__builtin_inff();
#pragma unroll
    for (int r = 0; r < 16; ++r) { const int c = (r & 3) + 8 * (r >> 2); if (dq - c < 0) p0[r] = NEG; if (dq - c - 32 < 0) p1[r] = NEG; }
}
__device__ __forceinline__ void partialSM(f32x16& p0, f32x16& p1, float& m_reg, float& mn, float& alpha) {
    float pmax = p0[0];
#pragma unroll
    for (int r = 1; r < 16; ++r) pmax = fmaxf(pmax, p0[r]);
#pragma unroll
    for (int r = 0; r < 16; ++r) pmax = fmaxf(pmax, p1[r]);
    { auto rr = __builtin_amdgcn_permlane32_swap(__float_as_uint(pmax), __float_as_uint(pmax), false, false); pmax = fmaxf(__uint_as_float(rr[0]), __uint_as_float(rr[1])); }
    constexpr float C2 = 1.4426950408889634f * SCALE;
    if (__builtin_expect(__all((pmax - m_reg) * SCALE <= THR), 1)) { mn = m_reg; alpha = 1.f; }
    else { mn = fmaxf(m_reg, pmax); alpha = __builtin_amdgcn_exp2f((m_reg - mn) * C2); m_reg = mn; }
    const float mnL = -mn * C2;
#pragma unroll
    for (int r = 0; r < 16; ++r) p0[r] = fmaf(p0[r], C2, mnL);
#pragma unroll
    for (int r = 0; r < 16; ++r) p1[r] = fmaf(p1[r], C2, mnL);
#pragma unroll
    for (int r = 0; r < 16; ++r) p0[r] = __builtin_amdgcn_exp2f(p0[r]);
}
__device__ __forceinline__ void finishSM(f32x16& p0, f32x16& p1, float alpha, float& l_reg, bf16x8& pa0, bf16x8& pa1, bf16x8& pa2, bf16x8& pa3) {
#pragma unroll
    for (int r = 0; r < 16; ++r) p1[r] = __builtin_amdgcn_exp2f(p1[r]);
    float ps = 0;
#pragma unroll
    for (int r = 0; r < 16; ++r) ps += p0[r];
#pragma unroll
    for (int r = 0; r < 16; ++r) ps += p1[r];
    { auto rr = __builtin_amdgcn_permlane32_swap(__float_as_uint(ps), __float_as_uint(ps), false, false); ps = __uint_as_float(rr[0]) + __uint_as_float(rr[1]); }
    l_reg = l_reg * alpha + ps;
#define PK4(P, B_, OUT) do { unsigned a0 = cvtpk(P[B_+0], P[B_+1]), a1 = cvtpk(P[B_+2], P[B_+3]); unsigned b0 = cvtpk(P[B_+4], P[B_+5]), b1 = cvtpk(P[B_+6], P[B_+7]); \
        auto r0 = __builtin_amdgcn_permlane32_swap(a0, b0, false, false); auto r1 = __builtin_amdgcn_permlane32_swap(a1, b1, false, false); \
        u32x4 w = {r0[0], r1[0], r0[1], r1[1]}; OUT = __builtin_bit_cast(bf16x8, w); } while (0)
    PK4(p0, 0, pa0); PK4(p0, 8, pa1); PK4(p1, 0, pa2); PK4(p1, 8, pa3);
#undef PK4
}
template <int KB>
__device__ __forceinline__ void qkt(f32x16& p0, f32x16& p1, const LAS unsigned char* K_lds, int r32, int hi, const bf16x8* qr, const LAS unsigned char* qsp) {
    p0 = f32x16{}; p1 = f32x16{};
    const LAS unsigned char* kb[4];
#pragma unroll
    for (int dd = 0; dd < 4; ++dd) kb[dd] = K_lds + KB * SHM_K + KSWZ(r32, (dd * 16 + hi * 8) * 2);
#pragma unroll
    for (int d0 = 0; d0 < 12; ++d0) { const LAS unsigned char* a = kb[d0 & 3] + (d0 >> 2) * 128;
        const bf16x8 b0 = *(const LAS bf16x8*)a; const bf16x8 b1 = *(const LAS bf16x8*)(a + 32 * 384);
        bf16x8 qv; if (d0 < NQR) qv = qr[d0]; else qv = *(const LAS bf16x8*)(qsp + (d0 - NQR) * 1024);
        p0 = __builtin_amdgcn_mfma_f32_32x32x16_bf16(b0, qv, p0, 0, 0, 0);
        p1 = __builtin_amdgcn_mfma_f32_32x32x16_bf16(b1, qv, p1, 0, 0, 0); }
}
template <int VB>
__device__ __forceinline__ void pv_tile(f32x16* o, int vb0, bf16x8 pa0, bf16x8 pa1, bf16x8 pa2, bf16x8 pa3) {
#define TRRD(dst, off) asm volatile("ds_read_b64_tr_b16 %0, %1 offset:%2" : "=&v"(dst) : "v"(vb0), "i"(off) : "memory")
#define PV_D0(d0) do { s16x4 l0, l1, l2, l3, h0, h1, h2, h3; constexpr int b_ = VB * SHM_V + v_rd_off(d0, 0, 0); \
        TRRD(l0, b_); TRRD(h0, b_ + 2048); TRRD(l1, b_ + 4096); TRRD(h1, b_ + 6144); TRRD(l2, b_ + 8192); TRRD(h2, b_ + 10240); TRRD(l3, b_ + 12288); TRRD(h3, b_ + 14336); \
        asm volatile("s_waitcnt lgkmcnt(0)" ::: "memory"); SBAR(); \
        o[d0] = __builtin_amdgcn_mfma_f32_32x32x16_bf16(pa0, (bf16x8){l0[0], l0[1], l0[2], l0[3], h0[0], h0[1], h0[2], h0[3]}, o[d0], 0, 0, 0); \
        o[d0] = __builtin_amdgcn_mfma_f32_32x32x16_bf16(pa1, (bf16x8){l1[0], l1[1], l1[2], l1[3], h1[0], h1[1], h1[2], h1[3]}, o[d0], 0, 0, 0); \
        o[d0] = __builtin_amdgcn_mfma_f32_32x32x16_bf16(pa2, (bf16x8){l2[0], l2[1], l2[2], l2[3], h2[0], h2[1], h2[2], h2[3]}, o[d0], 0, 0, 0); \
        o[d0] = __builtin_amdgcn_mfma_f32_32x32x16_bf16(pa3, (bf16x8){l3[0], l3[1], l3[2], l3[3], h3[0], h3[1], h3[2], h3[3]}, o[d0], 0, 0, 0); } while (0)
    PV_D0(0); PV_D0(1); PV_D0(2); PV_D0(3);
#undef PV_D0
#undef TRRD
}
__device__ __forceinline__ void attn_unit(int bh, int qb, const bf16_t* __restrict__ Qg, const bf16_t* __restrict__ Kg, const bf16_t* __restrict__ Vg, bf16_t* MIX, const float* __restrict__ onw_g, LAS unsigned char* lds, int tid, unsigned* qctr, LAS int* qslot) {
    const int wid = __builtin_amdgcn_readfirstlane(tid >> 6), lane = tid & 63, r32 = lane & 31, hi = lane >> 5;
    const int P0 = qb * QB, NT = (P0 + QB) / KVBLK;
    const bf16_t* Kh = Kg + (size_t)bh * SEQ * 192; const bf16_t* Vh = Vg + (size_t)bh * SEQ * 128;
    const bf16_t* Qw = Qg + ((size_t)bh * SEQ + P0 + wid * QBLK + r32) * 192 + hi * 8;
    LAS unsigned char* V_lds = lds; LAS unsigned char* K_lds = lds + OFF_K;
    LAS float* ws = (LAS float*)(lds + OFF_WS) + wid * 64; LAS float* li_l = ws; LAS float* al_l = ws + 32;
    const int qlo = P0 + wid * QBLK, qm = qlo + r32 - 4 * hi;
    const int sr = tid >> 4, sc = (tid & 15) * 8, vst0 = v_st(sr, sc), vst1 = v_st(32 + sr, sc);
    int kws[3], kgo[3];
#pragma unroll
    for (int i = 0; i < 3; ++i) { const int id = tid + 512 * i, row = id / 24, c = id - row * 24; kws[i] = KSWZ(row, c * 16); kgo[i] = row * 192 + c * 8; }
    const int vb0 = (int)(uintptr_t)V_lds + v_rd_base(lane);
    bf16x8 st_v0, st_v1, st_k0, st_k1, st_k2;
#define VMW() asm volatile("s_waitcnt vmcnt(0)" ::: "memory")
#define SLOAD(k0) do { st_v0 = *(const bf16x8*)(Vh + (size_t)((k0) + sr) * 128 + sc); st_v1 = *(const bf16x8*)(Vh + (size_t)((k0) + 32 + sr) * 128 + sc); \
        st_k0 = *(const bf16x8*)(Kh + (size_t)(k0) * 192 + kgo[0]); st_k1 = *(const bf16x8*)(Kh + (size_t)(k0) * 192 + kgo[1]); st_k2 = *(const bf16x8*)(Kh + (size_t)(k0) * 192 + kgo[2]); } while (0)
#define SWRITE_K(bf) do { *(LAS bf16x8*)(K_lds + (bf) * SHM_K + kws[0]) = st_k0; *(LAS bf16x8*)(K_lds + (bf) * SHM_K + kws[1]) = st_k1; *(LAS bf16x8*)(K_lds + (bf) * SHM_K + kws[2]) = st_k2; } while (0)
#define SWRITE_V(bf) do { *(LAS bf16x8*)(V_lds + (bf) * SHM_V + vst0) = st_v0; *(LAS bf16x8*)(V_lds + (bf) * SHM_V + vst1) = st_v1; } while (0)
#define KBASE(t) ((t) * KVBLK)
#define MASKT(P0_, P1_, t) do { const int kb_ = KBASE(t); if (kb_ + KVBLK - 1 > qlo) mask_tile(P0_, P1_, qm - kb_); } while (0)
#define RESC(a) do { if (__any((a) < 1.f)) { if (hi == 0) al_l[r32] = (a); asm volatile("s_waitcnt lgkmcnt(0)" ::: "memory"); \
        _Pragma("unroll") for (int d_ = 0; d_ < 4; ++d_) _Pragma("unroll") for (int r = 0; r < 16; ++r) o[d_][r] *= al_l[crow(r, hi)]; } } while (0)
    bf16x8 qr[NQR]; LAS unsigned char* qsp = lds + OFF_QS + wid * ((12 - NQR) * 1024) + lane * 16;
#pragma unroll
    for (int d0 = 0; d0 < NQR; ++d0) qr[d0] = *(const bf16x8*)(Qw + d0 * 16);
#pragma unroll
    for (int d0 = NQR; d0 < 12; ++d0) { const bf16x8 t_ = *(const bf16x8*)(Qw + d0 * 16); *(LAS bf16x8*)(qsp + (d0 - NQR) * 1024) = t_; }
    SLOAD(0); VMW(); SWRITE_K(0); SWRITE_V(0);
    __syncthreads();
    float m_reg = -1e30f, l_reg = 0.f; f32x16 o[4] = {};
    f32x16 pA0, pA1; float mnA, alA; bf16x8 pa0, pa1, pa2, pa3;
#define STEP(t, BF) do { \
        if ((t) + 1 < NT) { SLOAD(KBASE((t) + 1)); } SBAR(); \
        qkt<BF>(pA0, pA1, K_lds, r32, hi, qr, qsp); \
        MASKT(pA0, pA1, (t)); partialSM(pA0, pA1, m_reg, mnA, alA); RESC(alA); \
        finishSM(pA0, pA1, alA, l_reg, pa0, pa1, pa2, pa3); SBAR(); \
        pv_tile<BF>(o, vb0, pa0, pa1, pa2, pa3); \
        if ((t) + 1 < NT) { VMW(); SWRITE_K(1 - BF); SWRITE_V(1 - BF); } \
        __syncthreads(); } while (0)
    for (int t = 0; t < NT; t += 2) { STEP(t, 0); STEP(t + 1, 1); }
#undef STEP
    int nxt_unit = 0; if (tid == 0) nxt_unit = (int)atomicAdd(qctr, 1u);
    if (hi == 0) li_l[r32] = l_reg;
    asm volatile("s_waitcnt lgkmcnt(0)" ::: "memory");
    const int b = bh >> 2, h = bh & 3;
    float wn[4];
#pragma unroll
    for (int d0 = 0; d0 < 4; ++d0) wn[d0] = onw_g[h * 128 + d0 * 32 + r32];
    bf16_t* Ow = MIX + ((size_t)b * SEQ + P0 + wid * QBLK) * DM + h * 128 + r32;
#pragma unroll
    for (int r = 0; r < 16; ++r) { const int orow = crow(r, hi); const float rl = __builtin_amdgcn_rcpf(li_l[orow]);
        float v[4], ss = 0.f;
#pragma unroll
        for (int d0 = 0; d0 < 4; ++d0) { v[d0] = o[d0][r] * rl; ss += v[d0] * v[d0]; }
        ss = row16_sum(ss); ss += __shfl_xor(ss, 16);
        const float rn = __builtin_amdgcn_rsqf(ss * (1.f / 128) + EPS);
#pragma unroll
        for (int d0 = 0; d0 < 4; ++d0) { const float val = v[d0] * rn * wn[d0]; const float vn = __builtin_bit_cast(float, __builtin_amdgcn_mov_dpp(__builtin_bit_cast(int, val), 0xB1, 0xF, 0xF, true));
            if ((r32 & 1) == 0) *(unsigned*)(Ow + (size_t)orow * DM + d0 * 32) = cvtpk(val, vn); } }
    if (tid == 0) *qslot = nxt_unit;
    __syncthreads();
#undef VMW
#undef SLOAD
#undef SWRITE_K
#undef SWRITE_V
#undef KBASE
#undef MASKT
#undef RESC
}
#undef SBAR
#undef KSWZ
#undef LAS
}

namespace gdn {
#define LAS __attribute__((address_space(3)))
typedef float f32x2_t __attribute__((ext_vector_type(2))); typedef __bf16 bf16x2_t __attribute__((ext_vector_type(2)));
__device__ __forceinline__ unsigned cvtpk(float lo, float hi) { const f32x2_t v = {lo, hi}; const bf16x2_t b = __builtin_convertvector(v, bf16x2_t); return __builtin_bit_cast(unsigned, b); }
__device__ __forceinline__ bf16x8 pack2(f32x4 a, f32x4 b) { u32x4 w = {cvtpk(a[0], a[1]), cvtpk(a[2], a[3]), cvtpk(b[0], b[1]), cvtpk(b[2], b[3])}; return __builtin_bit_cast(bf16x8, w); }
__device__ __forceinline__ float wave_incl_scan(float g, int lane) {
#pragma unroll
    for (int o = 1; o < 64; o <<= 1) { const int src_ = lane >= o ? lane - o : lane; const float t = __builtin_bit_cast(float, __builtin_amdgcn_ds_bpermute(src_ << 2, __builtin_bit_cast(int, g))); if (lane >= o) g += t; }
    return g;
}
__device__ __forceinline__ int kperm(int c) { const int u = c & 31; return (c & ~31) + ((u & 16) ? 8 * ((u - 16) >> 2) + 4 + (u & 3) : 8 * (u >> 2) + (u & 3)); }
__device__ __forceinline__ void scale8(bf16x8 x, float s, u32x4& o) {
    float f[8];
#pragma unroll
    for (int t = 0; t < 8; ++t) f[t] = bf2f((bf16_t)x[t]) * s;
    o.x = cvtpk(f[0], f[1]); o.y = cvtpk(f[2], f[3]); o.z = cvtpk(f[4], f[5]); o.w = cvtpk(f[6], f[7]);
}
constexpr int CL_LM = 64 * 68 * 4, CL_WAVE = CL_LM + 512;
__device__ __forceinline__ void cl_copy_out(const LAS unsigned char* X, bf16_t* dst, int lane) {
#pragma unroll 2
    for (int it = 0; it < 8; ++it) { const int id = it * 64 + lane, row = id >> 3, pc = id & 7; const u32x4 v = *(const LAS u32x4*)(X + row * 128 + pc * 16); *(u32x4*)(dst + (size_t)row * NPROJ + pc * 8) = v; }
}
__device__ __forceinline__ void chunk_local(const P& p, LAS unsigned char* lds, int tix, int bix) {
    const int lane = tix & 63, wid = __builtin_amdgcn_readfirstlane(tix >> 6), fr = lane & 15, fq = lane >> 4;
    LAS float* Lm = (LAS float*)(lds + wid * CL_WAVE); LAS float* Gl = Lm + 64 * 68; LAS float* Bl = Gl + 64; LAS bf16_t* X = (LAS bf16_t*)Lm;
    bf16_t* PROJ = WSP(bf16_t, WS_PROJ);
#pragma clang loop unroll(disable)
    for (int item = bix * 8 + wid; item < BATCH * 4 * 32; item += (int)gridDim.x * 8) {
        const int bh = item >> 5, c = item & 31, b = bh >> 2, h = bh & 3; const size_t t0 = (size_t)bh * SEQ + c * 64;
        bf16_t* kp = WSP(bf16_t, WS_GK) + t0 * 128; bf16_t* qp = WSP(bf16_t, WS_GQ) + t0 * 128; bf16_t* vp = WSP(bf16_t, WS_GV) + t0 * 128;
        bf16_t* orow = PROJ + ((size_t)b * SEQ + c * 64) * NPROJ + OFF_GQ + h * 128;
        const float G = wave_incl_scan(WSP(float, WS_GG)[t0 + lane], opq_v(lane));
        Gl[lane] = G; Bl[lane] = WSP(float, WS_GBETA)[t0 + lane];
        if (lane == 63) WSP(float, WS_CD)[item] = __expf(G);
        bf16x8 kf[4][4];
#pragma unroll
        for (int mt = 0; mt < 4; ++mt)
#pragma unroll
            for (int kt = 0; kt < 4; ++kt) kf[mt][kt] = *(const bf16x8*)(kp + (size_t)(16 * mt + fr) * 128 + 32 * kt + 8 * fq);
        bf16x8 qfa[4][4];
#pragma unroll
        for (int mt = 0; mt < 2; ++mt)
#pragma unroll
            for (int kt = 0; kt < 4; ++kt) qfa[mt][kt] = *(const bf16x8*)(qp + (size_t)(16 * mt + fr) * 128 + 32 * kt + 8 * fq);
#pragma unroll
        for (int mt = 0; mt < 4; ++mt) { const f32x4 Gi = *(const LAS f32x4*)(Gl + 16 * mt + 4 * fq);
            if (mt == 0) {
#pragma unroll
                for (int m2 = 2; m2 < 4; ++m2)
#pragma unroll
                    for (int kt = 0; kt < 4; ++kt) qfa[m2][kt] = *(const bf16x8*)(qp + (size_t)(16 * m2 + fr) * 128 + 32 * kt + 8 * fq); }
#pragma unroll
            for (int nt = 0; nt < 4; ++nt) { f32x4 acc = {0.f, 0.f, 0.f, 0.f};
                if (nt <= mt) {
#pragma unroll
                    for (int kt = 0; kt < 4; ++kt) acc = __builtin_amdgcn_mfma_f32_16x16x32_bf16(qfa[mt][kt], kf[nt][kt], acc, 0, 0, 0); }
                const int j = 16 * nt + fr; const float Gj = Gl[j]; const int pj = kperm(j);
#pragma unroll
                for (int r = 0; r < 4; ++r) { const int i = 16 * mt + 4 * fq + r; X[i * 64 + pj] = f2bf((i >= j) ? acc[r] * __expf(Gi[r] - Gj) : 0.f); } } }
        cl_copy_out((const LAS unsigned char*)X, orow + 64, lane);
#pragma unroll
        for (int mt = 0; mt < 4; ++mt) { const f32x4 Gi = *(const LAS f32x4*)(Gl + 16 * mt + 4 * fq), Bi = *(const LAS f32x4*)(Bl + 16 * mt + 4 * fq);
#pragma unroll
            for (int nt = 0; nt <= mt; ++nt) { f32x4 acc = {0.f, 0.f, 0.f, 0.f};
#pragma unroll
                for (int kt = 0; kt < 4; ++kt) acc = __builtin_amdgcn_mfma_f32_16x16x32_bf16(kf[mt][kt], kf[nt][kt], acc, 0, 0, 0);
                const int j = 16 * nt + fr; const float Gj = Gl[j];
#pragma unroll
                for (int r = 0; r < 4; ++r) { const int i = 16 * mt + 4 * fq + r; Lm[i * 68 + j] = (i > j) ? Bi[r] * acc[r] * __expf(Gi[r] - Gj) : 0.f; } } }
        asm volatile("" ::: "memory");
        {
            float Tc[64];
#pragma unroll
            for (int i = 0; i < 64; ++i) { float a = (lane == i) ? 1.f : 0.f;
#pragma unroll
                for (int j4 = 0; j4 < i; j4 += 4) { const f32x4 l4 = *(const LAS f32x4*)(Lm + i * 68 + j4);
#pragma unroll
                    for (int r = 0; r < 4; ++r) if (j4 + r < i) a -= l4[r] * Tc[j4 + r]; }
                Tc[i] = a; }
            asm volatile("" ::: "memory");
            const int pl = kperm(lane);
#pragma unroll
            for (int i = 0; i < 64; ++i) X[i * 64 + pl] = f2bf(Tc[i]);
        }
        cl_copy_out((const LAS unsigned char*)X, orow, lane);
        asm volatile("s_waitcnt vmcnt(0) lgkmcnt(0)" ::: "memory");
        {
            const float Glast = Gl[63]; const int scp = lane & 7; LAS bf16_t* X2 = (LAS bf16_t*)Lm;
#pragma clang loop unroll(disable)
            for (int hf = 0; hf < 4; ++hf) {
                bf16x8 q0[2], q1[2], k0[2], k1[2], v0[2], v1[2];
#pragma unroll
                for (int u = 0; u < 2; ++u) { const size_t ro = (size_t)((hf * 2 + u) * 8 + (lane >> 3)) * 128 + scp * 16;
                    q0[u] = *(const bf16x8*)(qp + ro); q1[u] = *(const bf16x8*)(qp + ro + 8); k0[u] = *(const bf16x8*)(kp + ro); k1[u] = *(const bf16x8*)(kp + ro + 8); v0[u] = *(const bf16x8*)(vp + ro); v1[u] = *(const bf16x8*)(vp + ro + 8); }
#pragma unroll
                for (int u = 0; u < 2; ++u) { const int row = (hf * 2 + u) * 8 + (lane >> 3); const float Gi = Gl[row], bi = Bl[row]; const float eg = __expf(Gi), ed = __expf(Glast - Gi);
                    const size_t ro = (size_t)row * 128 + scp * 16; const int pc = (scp >> 1) * 32 + (scp & 1) * 4;
                    u32x4 a_, b_;
                    scale8(q0[u], eg, a_); scale8(q1[u], eg, b_);
                    { bf16_t* d = qp + (size_t)row * 128 + pc; *(u32x2*)(d) = (u32x2){a_.x, a_.y}; *(u32x2*)(d + 8) = (u32x2){a_.z, a_.w}; *(u32x2*)(d + 16) = (u32x2){b_.x, b_.y}; *(u32x2*)(d + 24) = (u32x2){b_.z, b_.w}; }
                    scale8(k0[u], -eg * bi, a_); scale8(k1[u], -eg * bi, b_);
                    { bf16_t* d = kp + (size_t)row * 128 + pc; *(u32x2*)(d) = (u32x2){a_.x, a_.y}; *(u32x2*)(d + 8) = (u32x2){a_.z, a_.w}; *(u32x2*)(d + 16) = (u32x2){b_.x, b_.y}; *(u32x2*)(d + 24) = (u32x2){b_.z, b_.w}; }
                    scale8(v0[u], bi, a_); scale8(v1[u], bi, b_); *(u32x4*)(vp + ro) = a_; *(u32x4*)(vp + ro + 8) = b_;
                    const int pi = kperm(row);
#pragma unroll
                    for (int t = 0; t < 8; ++t) { X2[(scp * 16 + t) * 64 + pi] = f2bf(bf2f((bf16_t)k0[u][t]) * ed); X2[(scp * 16 + 8 + t) * 64 + pi] = f2bf(bf2f((bf16_t)k1[u][t]) * ed); } }
            }
            bf16_t* krow = orow + 512;
#pragma unroll 2
            for (int it = 0; it < 16; ++it) { const int id = it * 64 + lane, row = id >> 4, pcs = id & 15; const u32x4 v = *(const LAS u32x4*)((const LAS unsigned char*)X2 + row * 256 + pcs * 16); *(u32x4*)(krow + (size_t)row * NPROJ + pcs * 8) = v; }
        }
    }
}
constexpr int RS128 = 288, RS64 = 160;
constexpr int L_QG = 0, L_KG = L_QG + 64 * RS128, L_VV = L_KG + 64 * RS128, L_KDT = L_VV + 64 * RS128, L_TT = L_KDT + 128 * RS64, L_AI = L_TT + 64 * RS64, L_PART = L_AI + 64 * RS64, L_OT = L_PART + 2048, L_END = L_OT + 64 * RS128;
#define GSB() __builtin_amdgcn_sched_barrier(0)
__device__ __forceinline__ void scan(const P& p, LAS unsigned char* lds, int tix, int bh) {
    const int lane = tix & 63, w = __builtin_amdgcn_readfirstlane(tix >> 6), fr = lane & 15, fq = lane >> 4, e0 = 16 * w, b = bh >> 2, h = bh & 3;
    const int srow = tix >> 3, scp = tix & 7;
    const bf16_t* gq = WSP(bf16_t, WS_GQ) + ((size_t)bh * SEQ + srow) * 128 + scp * 16; const bf16_t* gk = WSP(bf16_t, WS_GK) + ((size_t)bh * SEQ + srow) * 128 + scp * 16;
    const bf16_t* gv = WSP(bf16_t, WS_GV) + ((size_t)bh * SEQ + srow) * 128 + scp * 16;
    const bf16_t* gt = WSP(bf16_t, WS_PROJ) + ((size_t)b * SEQ + srow) * NPROJ + OFF_GQ + h * 128;
    const bf16_t* gz = WSP(bf16_t, WS_PROJ) + ((size_t)b * SEQ + srow) * NPROJ + OFF_GZ + h * 128 + scp * 16;
    bf16_t* mo = WSP(bf16_t, WS_MIX) + ((size_t)b * SEQ + srow) * DM + 512 + h * 128 + scp * 16;
    const float* gcd = WSP(float, WS_CD) + bh * 32;
    const float nw = p.gdn_norm_w[e0 + fr];
    const LAS unsigned char* fbase128 = lds + fr * RS128 + fq * 16; const LAS unsigned char* fbase64 = lds + fr * RS64 + fq * 16;
    LAS unsigned char* kdt_dst = lds + L_KDT + (2 * srow + (scp >> 2)) * RS64 + (scp & 3) * 32;
    f32x4 S[8];
#pragma unroll
    for (int i = 0; i < 8; ++i) S[i] = (f32x4){0.f, 0.f, 0.f, 0.f};
    bf16x8 pq0, pq1, pk0, pk1, pv0, pv1, pT, pA, pd0, pd1, pz0, pz1; float cd = 1.f, cdn = 1.f;
#define PREFETCH(c) do { const size_t o_ = (size_t)(c) * 64 * 128; pq0 = *(const bf16x8*)(gq + o_); pq1 = *(const bf16x8*)(gq + o_ + 8); pk0 = *(const bf16x8*)(gk + o_); pk1 = *(const bf16x8*)(gk + o_ + 8); \
        pv0 = *(const bf16x8*)(gv + o_); pv1 = *(const bf16x8*)(gv + o_ + 8); const size_t t_ = (size_t)(c) * 64 * NPROJ; pT = *(const bf16x8*)(gt + t_ + scp * 8); pA = *(const bf16x8*)(gt + t_ + 64 + scp * 8); \
        pd0 = *(const bf16x8*)(gt + t_ + 512 + scp * 16); pd1 = *(const bf16x8*)(gt + t_ + 512 + scp * 16 + 8); cdn = gcd[c]; } while (0)
#define COPYIN() do { *(LAS bf16x8*)(lds + L_QG + srow * RS128 + scp * 32) = pq0; *(LAS bf16x8*)(lds + L_QG + srow * RS128 + scp * 32 + 16) = pq1; \
        *(LAS bf16x8*)(lds + L_KG + srow * RS128 + scp * 32) = pk0; *(LAS bf16x8*)(lds + L_KG + srow * RS128 + scp * 32 + 16) = pk1; \
        *(LAS bf16x8*)(lds + L_VV + srow * RS128 + scp * 32) = pv0; *(LAS bf16x8*)(lds + L_VV + srow * RS128 + scp * 32 + 16) = pv1; \
        *(LAS bf16x8*)(kdt_dst) = pd0; *(LAS bf16x8*)(kdt_dst + 16) = pd1; \
        *(LAS bf16x8*)(lds + L_TT + srow * RS64 + scp * 16) = pT; *(LAS bf16x8*)(lds + L_AI + srow * RS64 + scp * 16) = pA; cd = cdn; } while (0)
#define FR128(base, mt, kt) (*(const LAS bf16x8*)(fbase128 + (base) + (mt) * 16 * RS128 + (kt) * 64))
#define FR64(base, mt, kt) (*(const LAS bf16x8*)(fbase64 + (base) + (mt) * 16 * RS64 + (kt) * 64))
    PREFETCH(0);
    COPYIN();
    __syncthreads();
#pragma clang loop unroll(disable)
    for (int c = 0; c < 32; ++c) {
        const float cdc = cd;
        if (c + 1 < 32) PREFETCH(c + 1);
        pz0 = *(const bf16x8*)(gz + (size_t)c * 64 * NPROJ); pz1 = *(const bf16x8*)(gz + (size_t)c * 64 * NPROJ + 8);
        bf16x8 sb[4];
#pragma unroll
        for (int kt = 0; kt < 4; ++kt) sb[kt] = pack2(S[2 * kt], S[2 * kt + 1]);
        f32x4 R[4], O[4], VN[4]; bf16x8 f[8], g[8];
#define LD8_128(dst, base, kt0) do { _Pragma("unroll") for (int mt = 0; mt < 4; ++mt) { dst[mt * 2] = FR128(base, mt, kt0); dst[mt * 2 + 1] = FR128(base, mt, (kt0) + 1); } } while (0)
#define LD8_64(dst, base, mt0) do { _Pragma("unroll") for (int mt = 0; mt < 4; ++mt) { dst[mt * 2] = FR64(base, (mt0) + mt, 0); dst[mt * 2 + 1] = FR64(base, (mt0) + mt, 1); } } while (0)
#define MM8(ACC, fr_, B0, B1) do { _Pragma("unroll") for (int mt = 0; mt < 4; ++mt) ACC[mt] = __builtin_amdgcn_mfma_f32_16x16x32_bf16(fr_[mt * 2], B0, ACC[mt], 0, 0, 0); \
                                   _Pragma("unroll") for (int mt = 0; mt < 4; ++mt) ACC[mt] = __builtin_amdgcn_mfma_f32_16x16x32_bf16(fr_[mt * 2 + 1], B1, ACC[mt], 0, 0, 0); } while (0)
        GSB();
        LD8_128(f, L_KG, 0); LD8_128(g, L_KG, 2);
#pragma unroll
        for (int mt = 0; mt < 4; ++mt)
#pragma unroll
            for (int j = 0; j < 4; ++j) R[mt][j] = bf2f(*(const LAS bf16_t*)(lds + L_VV + (16 * mt + 4 * fq + j) * RS128 + (e0 + fr) * 2));
        GSB();
        MM8(R, f, sb[0], sb[1]); LD8_128(f, L_QG, 0);
        GSB();
        MM8(R, g, sb[2], sb[3]); LD8_128(g, L_QG, 2);
        GSB();
        bf16x8 rb[2] = {pack2(R[0], R[1]), pack2(R[2], R[3])};
#pragma unroll
        for (int mt = 0; mt < 4; ++mt) { VN[mt] = (f32x4){0.f, 0.f, 0.f, 0.f}; O[mt] = (f32x4){0.f, 0.f, 0.f, 0.f}; }
        MM8(O, f, sb[0], sb[1]); LD8_64(f, L_TT, 0);
        GSB();
        MM8(O, g, sb[2], sb[3]); LD8_64(g, L_AI, 0);
        GSB();
        MM8(VN, f, rb[0], rb[1]); LD8_64(f, L_KDT, 0);
        GSB();
        bf16x8 vb[2] = {pack2(VN[0], VN[1]), pack2(VN[2], VN[3])};
#pragma unroll
        for (int mt = 0; mt < 8; ++mt) S[mt] = S[mt] * cdc;
        MM8(O, g, vb[0], vb[1]); LD8_64(g, L_KDT, 4);
        GSB();
        MM8(S, f, vb[0], vb[1]);
        GSB();
        { f32x4* S4 = S + 4; MM8(S4, g, vb[0], vb[1]); }
        GSB();
#undef LD8_128
#undef LD8_64
#undef MM8
        LAS float* part = (LAS float*)(lds + L_PART);
#pragma unroll
        for (int mt = 0; mt < 4; ++mt) { f32x4 s4 = O[mt] * O[mt];
#pragma unroll
            for (int j = 0; j < 4; ++j) { s4[j] = row16_sum(s4[j]);
                *(LAS bf16_t*)(lds + L_OT + (16 * mt + 4 * fq + j) * RS128 + (e0 + fr) * 2) = f2bf(O[mt][j] * nw); }
            if (fr == 0) *(LAS f32x4*)(part + w * 64 + 16 * mt + 4 * fq) = s4; }
        __syncthreads();
        if (c + 1 < 32) COPYIN();
        {
            float tot = 0.f;
#pragma unroll
            for (int ww = 0; ww < 8; ++ww) tot += part[ww * 64 + srow];
            const float rn = __builtin_amdgcn_rsqf(tot * (1.f / 128) + EPS);
            const bf16x8 o0 = *(const LAS bf16x8*)(lds + L_OT + srow * RS128 + scp * 32), o1 = *(const LAS bf16x8*)(lds + L_OT + srow * RS128 + scp * 32 + 16);
            float fo[8], fz[8]; u32x4 r0, r1;
            bf8_to_f(o0, fo); bf8_to_f(pz0, fz);
#pragma unroll
            for (int t = 0; t < 8; ++t) fo[t] = fo[t] * rn * (fz[t] * __builtin_amdgcn_rcpf(1.f + __expf(-fz[t])));
            r0.x = cvtpk(fo[0], fo[1]); r0.y = cvtpk(fo[2], fo[3]); r0.z = cvtpk(fo[4], fo[5]); r0.w = cvtpk(fo[6], fo[7]);
            bf8_to_f(o1, fo); bf8_to_f(pz1, fz);
#pragma unroll
            for (int t = 0; t < 8; ++t) fo[t] = fo[t] * rn * (fz[t] * __builtin_amdgcn_rcpf(1.f + __expf(-fz[t])));
            r1.x = cvtpk(fo[0], fo[1]); r1.y = cvtpk(fo[2], fo[3]); r1.z = cvtpk(fo[4], fo[5]); r1.w = cvtpk(fo[6], fo[7]);
            *(u32x4*)(mo + (size_t)c * 64 * DM) = r0; *(u32x4*)(mo + (size_t)c * 64 * DM + 8) = r1;
        }
        __syncthreads();
    }
#undef PREFETCH
#undef COPYIN
#undef FR128
#undef FR64
}
#undef GSB
#undef LAS
}

__device__ __forceinline__ void ph_mixers(const P& p, unsigned char* lds) {
    const int tix = opq_v(threadIdx.x), bix = opq_s(blockIdx.x); const int G = (int)gridDim.x;
    __attribute__((address_space(3))) unsigned char* l3 = (__attribute__((address_space(3))) unsigned char*)lds;
#pragma clang loop unroll(disable)
    for (int s = bix; s < BATCH * 4; s += G) gdn::scan(p, l3, tix, (s & 7) * 8 + (s >> 3));

    const bool perx = (G % 8 == 0) && G >= 8;
    const int xq = perx ? (bix & 7) : 0; const int nunits = perx ? 64 : 512;
    unsigned* ctr = WSP(unsigned, WS_SMALL + SM_QCTR) + xq * 64;
    __attribute__((address_space(3))) int* slot = (__attribute__((address_space(3))) int*)(lds + 150016);
    if (tix == 0) *slot = (int)atomicAdd(ctr, 1u);
    __syncthreads();
    for (;;) {
        const int u = __builtin_amdgcn_readfirstlane(*slot);
        if (u >= nunits) break;
        const int bh = perx ? xq * 8 + (u & 7) : (u & 63), qb = 7 - (perx ? (u >> 3) : (u >> 6));
        att::attn_unit(bh, qb, WSP(bf16_t, WS_Q), WSP(bf16_t, WS_K), WSP(bf16_t, WS_V), WSP(bf16_t, WS_MIX), p.mla_out_norm_w, l3, tix, ctr, slot);
    }
}
__device__ __forceinline__ void ph_gdn_chunk_local(const P& p, unsigned char* lds) {
    const int tix = opq_v(threadIdx.x), bix = opq_s(blockIdx.x);
    gdn::chunk_local(p, (__attribute__((address_space(3))) unsigned char*)lds, tix, bix);
}

#define XLAS __attribute__((address_space(3)))
#define XB_TMO      128
#define XB_XCNT(j)  (256  + 64 * (j))
#define XB_XSUB(j)  (1280 + 64 * (j))
#define XB_XGEN(j)  (2304 + 64 * (j))
#define XB_TOP      3328
#define XB_TOPGEN   3392
#define XCD_BAR_WORDS 3456
#define XB_SPIN_CAP (1u << 18)

__device__ __forceinline__ unsigned xb_ld(unsigned* p)              { return __hip_atomic_load(p, __ATOMIC_RELAXED, __HIP_MEMORY_SCOPE_AGENT); }
__device__ __forceinline__ unsigned xb_add(unsigned* p, unsigned v) { return __hip_atomic_fetch_add(p, v, __ATOMIC_RELAXED, __HIP_MEMORY_SCOPE_AGENT); }
__device__ __forceinline__ unsigned xb_xcc_id() { return (unsigned)__builtin_amdgcn_s_getreg((3 << 11) | 20) & 0xFu; }
#define XB_SPIN(cond, bar) do { unsigned _sp = 0; while (cond) { __builtin_amdgcn_s_sleep(1); \
    if ((++_sp & 255u) == 0u) { if (xb_ld(&(bar)[XB_TMO])) break; if (_sp > XB_SPIN_CAP) { atomicAdd(&(bar)[XB_TMO], 1u); break; } } } } while (0)

struct XcdBarrier {
    unsigned* bar; unsigned x;
    volatile XLAS unsigned* st;
};

__device__ __forceinline__ XcdBarrier xcd_barrier_post(unsigned* bar, volatile XLAS unsigned* st) {
    XcdBarrier b; b.bar = bar; b.x = xb_xcc_id(); b.st = st;
    if (threadIdx.x == 0) (void)xb_add(&bar[XB_XCNT(b.x)], 1u);
    return b;
}
__device__ __forceinline__ void xcd_barrier_complete(unsigned* bar, unsigned x, unsigned& nloc, unsigned& nx) {
    const unsigned G = gridDim.x * gridDim.y * gridDim.z;
    unsigned sum, cnt, mine, sp = 0u;
    for (;;) {
        sum = 0u; cnt = 0u; mine = 0u;
#pragma unroll
        for (unsigned j = 0; j < 16; ++j) { const unsigned c = xb_ld(&bar[XB_XCNT(j)]); sum += c; cnt += (c > 0u) ? 1u : 0u; mine = (j == x) ? c : mine; }
        if (sum == G) break;
        __builtin_amdgcn_s_sleep(1);
        if ((++sp & 255u) == 0u) { if (xb_ld(&bar[XB_TMO])) break; if (sp > XB_SPIN_CAP) { atomicAdd(&bar[XB_TMO], 1u); break; } }
    }
    nloc = mine > 0u ? mine : 1u; nx = cnt > 0u ? cnt : 1u;
}

__device__ __forceinline__ void xcd_barrier(const XcdBarrier& b) {
    asm volatile("s_waitcnt vmcnt(0)" ::: "memory");
    __syncthreads();
    if (threadIdx.x == 0) {
        unsigned* bar = b.bar;
        __builtin_amdgcn_s_waitcnt(0);
        unsigned nloc = b.st[0], nx = b.st[1];
        if (nloc == 0u) { xcd_barrier_complete(bar, b.x, nloc, nx); b.st[0] = nloc; b.st[1] = nx; }
        const unsigned old = xb_add(&bar[XB_XSUB(b.x)], 1u);
        const unsigned gen = old / nloc;
        if (old + 1u == (gen + 1u) * nloc) {
            __builtin_amdgcn_fence(__ATOMIC_RELEASE, "agent");
            asm volatile("s_waitcnt vmcnt(0)" ::: "memory");
            const unsigned og = xb_add(&bar[XB_TOP], 1u);
            const unsigned tg = og / nx;
            if (og + 1u == (tg + 1u) * nx) xb_add(&bar[XB_TOPGEN], 1u);
            else XB_SPIN(xb_ld(&bar[XB_TOPGEN]) == tg, bar);
            __builtin_amdgcn_fence(__ATOMIC_ACQUIRE, "agent");
            xb_add(&bar[XB_XGEN(b.x)], 1u);
            asm volatile("s_waitcnt vmcnt(0)" ::: "memory");
        } else {
            XB_SPIN(xb_ld(&bar[XB_XGEN(b.x)]) == gen, bar);
            __builtin_amdgcn_fence(__ATOMIC_ACQUIRE, "agent");
            asm volatile("s_waitcnt vmcnt(0)" ::: "memory");
        }
    }
    __syncthreads();
}

constexpr int LDS_BYTES = 155648;
#define GBAR() do { XcdBarrier b_; b_.bar = WSP(unsigned, WS_BAR); b_.x = xb_xcc_id(); b_.st = (volatile XLAS unsigned*)((XLAS unsigned char*)lds + 150032); xcd_barrier(b_); } while (0)
__device__ __forceinline__ void gemm_group(const P& p, PG8_LAS unsigned char* l3, unsigned char* lds, int g_lo) {
#pragma clang loop unroll(disable)
    for (int gi = g_lo; gi < g_lo + 3; ++gi) {
        const bf16_t* A; const bf16_t* Bt; int lda, ldb, N, K; bool perm = true;
        switch (gi) {
        case 0: A = WSP(bf16_t, WS_XN); lda = DM; Bt = WSP(bf16_t, WS_WIN); ldb = DM; N = NPROJ; K = DM; break;
        case 1: A = WSP(bf16_t, WS_PROJ); lda = NPROJ; Bt = WSP(bf16_t, WS_WUQ); ldb = 256; N = 768; K = 256; break;
        case 2: A = WSP(bf16_t, WS_PROJ) + OFF_KVLAT; lda = NPROJ; Bt = WSP(bf16_t, WS_WUKV); ldb = 256; N = 1024; K = 256; break;
        case 3: A = WSP(bf16_t, WS_MIX); lda = DM; Bt = WSP(bf16_t, WS_WOUT); ldb = DM; N = DM; K = DM; perm = false; break;
        case 4: A = WSP(bf16_t, WS_HB); lda = DM; Bt = WSP(bf16_t, WS_WUP); ldb = DM; N = DFF; K = DM; break;
        default: A = WSP(bf16_t, WS_ACT); lda = DFF; Bt = WSP(bf16_t, WS_WDOWN); ldb = DFF; N = DM; K = DFF; perm = false; break;
        }
        pg8::Gemm g{A, Bt, T, N, K, lda, ldb}; pg8::StaticOrder S; S.init(T, N, (int)gridDim.x, (int)blockIdx.x);
        GEpi E{gi, perm, p.ws, p.x, p.out};
        pg8::gemm_phase<GEpi, pg8::StaticOrder, true, true>(l3, g, S, E);
        if (gridDim.x == 256 && blockIdx.x >= 128) {
            if (gi == 0) wt_range(p, lds, WI0 + WI1 + WI2, WI0 + WI1 + WI2 + WI3 + WI4, ((int)blockIdx.x - 128) * 8, 128 * 8);
            if (gi == 2) wt_range(p, lds, WI0 + WI1 + WI2 + WI3 + WI4, WI0 + WI1 + WI2 + WI3 + WI4 + WI5, ((int)blockIdx.x - 128) * 8, 128 * 8);
        }
        if (gi == 0 || gi == 3 || gi == 4) GBAR();
    }
}
__global__ void __launch_bounds__(512, 2) mega_fwd(P p) {
    extern __shared__ __attribute__((aligned(16))) unsigned char lds[];
    cg::grid_group grid = cg::this_grid();
    PG8_LAS unsigned char* l3 = (PG8_LAS unsigned char*)lds;
    volatile XLAS unsigned* bst = (volatile XLAS unsigned*)((XLAS unsigned char*)lds + 150032);
    if (threadIdx.x < 2) bst[threadIdx.x] = 0u;
    __syncthreads();
    (void)xcd_barrier_post(WSP(unsigned, WS_BAR), bst);

    ph_prologue(p, lds);

    GBAR();
    if (gridDim.x == 0x7fffffu) grid.sync();
    gemm_group(p, l3, lds, 0);
    ph_gdn_prep(p);

    GBAR();
    ph_qk_finalize(p);
    ph_gdn_chunk_local(p, lds);
    GBAR();
    ph_mixers(p, lds);
    GBAR();
    gemm_group(p, l3, lds, 3);
}

extern "C" void kernel_launch(void* const* d_in, const int* in_sizes, int n_in, void* d_out, int out_size, void* d_ws, size_t ws_size, hipStream_t stream) {
    static int grid_blocks = 0;
    if (!grid_blocks) {
        int dev = 0, cus = 0, per_cu = 0;
        (void)hipGetDevice(&dev); (void)hipDeviceGetAttribute(&cus, hipDeviceAttributeMultiprocessorCount, dev);
        (void)hipFuncSetAttribute((const void*)mega_fwd, hipFuncAttributeMaxDynamicSharedMemorySize, LDS_BYTES);
        (void)hipOccupancyMaxActiveBlocksPerMultiprocessor(&per_cu, (const void*)mega_fwd, 512, LDS_BYTES);
        if (per_cu < 1) { fprintf(stderr, "kernel_launch: occupancy query says %d blocks/CU\n", per_cu); per_cu = 1; }
        grid_blocks = cus * 1;
    }
    P p{};
    p.x = (const float*)d_in[0]; p.positions = (const int*)d_in[1]; p.attn_norm_w = (const float*)d_in[2]; p.w_in = (const float*)d_in[3];
    p.q_lat_norm_w = (const float*)d_in[4]; p.w_uq = (const float*)d_in[5]; p.kv_lat_norm_w = (const float*)d_in[6]; p.w_ukv = (const float*)d_in[7];
    p.q_norm_w = (const float*)d_in[8]; p.k_norm_w = (const float*)d_in[9]; p.mla_out_norm_w = (const float*)d_in[10]; p.conv_w = (const float*)d_in[11];
    p.a_log = (const float*)d_in[12]; p.dt_bias = (const float*)d_in[13]; p.gdn_norm_w = (const float*)d_in[14]; p.w_out = (const float*)d_in[15];
    p.mlp_norm_w = (const float*)d_in[16]; p.w_up = (const float*)d_in[17]; p.w_down = (const float*)d_in[18];
    p.out = (float*)d_out; p.ws = (unsigned char*)d_ws;
    (void)hipMemsetAsync(p.ws + WS_BAR, 0, BAR_BYTES, stream);
    void* args[] = {&p};
    hipError_t e = hipLaunchCooperativeKernel((const void*)mega_fwd, dim3(grid_blocks), dim3(512), args, LDS_BYTES, stream);
    if (e != hipSuccess) fprintf(stderr, "cooperative launch failed: %s (grid %d)\n", hipGetErrorString(e), grid_blocks);
}
```

```cpp
#include <hip/hip_runtime.h>
#include <hip/hip_cooperative_groups.h>
#include <stdint.h>
#include <cstdio>
namespace cg = cooperative_groups;

typedef unsigned short bf16_t;
typedef short bf16x8 __attribute__((ext_vector_type(8)));
typedef float f32x4 __attribute__((ext_vector_type(4)));

constexpr int BATCH = 16, SEQ = 2048, DM = 1024, T = BATCH * SEQ, DFF = 4096;
constexpr int NPROJ = 2816, DIN = 2632;
constexpr int OFF_KVLAT = 256, OFF_KPE = 512, OFF_GQ = 576, OFF_GZ = 2112, OFF_GA = 2624;
constexpr float EPS = 1e-6f;
constexpr size_t MiB = 1u << 20;
constexpr size_t WS_WIN = 0, WS_WUQ = 6 * MiB, WS_WUKV = 6 * MiB + 512 * 1024, WS_WOUT = 7 * MiB, WS_WUP = 9 * MiB, WS_WDOWN = 17 * MiB;
constexpr size_t WS_SMALL = 25 * MiB;
constexpr size_t SM_SSQ_LAT = 0, SM_SSQ_QK = 256 * 1024, SM_SSQ_H = SM_SSQ_QK + 1536 * 1024, SM_QCTR = SM_SSQ_H + 128 * 1024, SM_ZERO_BYTES = SM_QCTR + 2048;
constexpr size_t WS_GAB = 28 * MiB, WS_GG = 29 * MiB, WS_GBETA = 29 * MiB + 512 * 1024;
constexpr size_t WS_PROJ = 32 * MiB;
constexpr size_t WS_XN = 208 * MiB, WS_QRAW = 208 * MiB, WS_KRAW = 256 * MiB, WS_MIX = 208 * MiB;
constexpr size_t WS_V = 288 * MiB, WS_Q = 320 * MiB, WS_K = 368 * MiB, WS_GQ = 416 * MiB, WS_GK = 448 * MiB, WS_GV = 480 * MiB;
constexpr size_t WS_HB = 288 * MiB, WS_ACT = 32 * MiB;

struct P {
    const float* x; const int* positions; const float* attn_norm_w; const float* w_in; const float* q_lat_norm_w; const float* w_uq;
    const float* kv_lat_norm_w; const float* w_ukv; const float* q_norm_w; const float* k_norm_w; const float* mla_out_norm_w;
    const float* conv_w; const float* a_log; const float* dt_bias; const float* gdn_norm_w; const float* w_out; const float* mlp_norm_w;
    const float* w_up; const float* w_down; float* out; unsigned char* ws;
};

__device__ __forceinline__ bf16_t f2bf(float f) { return __builtin_bit_cast(bf16_t, (__bf16)f); }
__device__ __forceinline__ float bf2f(bf16_t h) { return __builtin_bit_cast(float, (unsigned)h << 16); }
__device__ __forceinline__ float row16_sum(float s);
__device__ __forceinline__ float wave_sum(float v) { v = row16_sum(v); v += __shfl_xor(v, 16); v += __shfl_xor(v, 32); return v; }
__device__ __forceinline__ float row16_sum(float s) {
    s += __builtin_bit_cast(float, __builtin_amdgcn_mov_dpp(__builtin_bit_cast(int, s), 0xB1, 0xF, 0xF, true));
    s += __builtin_bit_cast(float, __builtin_amdgcn_mov_dpp(__builtin_bit_cast(int, s), 0x4E, 0xF, 0xF, true));
    s += __builtin_bit_cast(float, __builtin_amdgcn_mov_dpp(__builtin_bit_cast(int, s), 0x141, 0xF, 0xF, true));
    s += __builtin_bit_cast(float, __builtin_amdgcn_mov_dpp(__builtin_bit_cast(int, s), 0x140, 0xF, 0xF, true));
    return s;
}
__device__ __forceinline__ float wave_max(float v) {
#pragma unroll
    for (int o = 1; o < 64; o <<= 1) v = fmaxf(v, __shfl_xor(v, o));
    return v;
}
#define WSP(T_, off) ((T_*)(p.ws + (off)))
constexpr size_t WS_CD = 31 * MiB;
constexpr size_t WS_BAR = 31 * MiB + 65536, BAR_BYTES = 16384;
__device__ __forceinline__ int opq_v(int v) { asm volatile("" : "+v"(v)); return v; }
__device__ __forceinline__ int opq_s(int v) { asm volatile("" : "+s"(v)); return v; }

namespace pg8 {
#define PG8_LAS __attribute__((address_space(3)))
typedef unsigned short bf16_t;
typedef short bf16x8 __attribute__((ext_vector_type(8)));
typedef float f32x4 __attribute__((ext_vector_type(4)));
typedef unsigned u32x4 __attribute__((ext_vector_type(4)));
constexpr int BM = 256, BK = 64, HALF = 128, HTB = HALF * BK * 2  , STAGE_BYTES = 8 * HTB, NXCD = 8, WGM = 8;

__host__ __device__ __forceinline__ int lds_byte(int r, int c) { const int st = (r >> 4) * 2 + (c >> 5), rr = r & 15, cc = c & 31, ob = rr * 64 + cc * 2; return st * 1024 + (ob ^ (((ob >> 9) & 1) << 5)); }
__host__ __device__ __forceinline__ void stage_rc(int b, int& R, int& C) { const int st = b / 1024, sb = b % 1024, swz = sb ^ (((sb >> 9) & 1) << 5); R = (st >> 1) * 16 + swz / 64; C = (st & 1) * 32 + (swz % 64) / 2; }
__host__ __device__ __forceinline__ int perm32(int rho) { const int n = rho >> 4, i = rho & 15; return 8 * (i >> 2) + 4 * n + (i & 3); }

struct Unit { int pm, pn; };
struct Gemm { const bf16_t* A; const bf16_t* Bt; int M, N, K, lda, ldb; };

struct StaticOrder {
    int nM, nN, nwg, G, c;
    __host__ __device__ void init(int M, int N, int G_, int c_) { nM = M / BM; nN = N / BM; nwg = nM * nN; G = G_; c = c_; }
    __host__ __device__ bool next(int i, Unit& u) const {
        const long L = (long)i * G + c; if (L >= nwg) return false;
        int wgid = (int)L; { const int q = nwg / NXCD, r = nwg % NXCD, xcd = wgid % NXCD, off = wgid / NXCD; wgid = (xcd < r ? xcd * (q + 1) : r * (q + 1) + (xcd - r) * q) + off; }
        const int nig = WGM * nN, gid = wgid / nig, fm = gid * WGM, gsz = (nM - fm) < WGM ? (nM - fm) : WGM;
        u.pm = fm + ((wgid % nig) % gsz); u.pn = (wgid % nig) / gsz; return true;
    }
    __device__ __forceinline__ void a_ready(const Unit&) const {}
    __device__ __forceinline__ void done(const Unit&) const {}
};


__device__ __forceinline__ unsigned cvt_pk_bf16(float lo, float hi) { unsigned r; asm volatile("v_cvt_pk_bf16_f32 %0, %1, %2" : "=v"(r) : "v"(lo), "v"(hi)); return r; }
template <class Epi, class Sched, bool ALIGN_EPI = false, bool SP2 = false>
__device__ __forceinline__ void gemm_phase(PG8_LAS unsigned char* lds, const Gemm g, const Sched& S, const Epi& E) {
    const int tid = opq_v(threadIdx.x), wid = __builtin_amdgcn_readfirstlane(tid >> 6), lane = tid & 63, wr = wid >> 2, wc = wid & 3, fr = lane & 15, fq = lane >> 4;
    const int K = g.K, nt = K / BK;
    unsigned voffA[2], voffB[2];
#pragma unroll
    for (int i = 0; i < 2; ++i) { int R, C; stage_rc(tid * 16 + i * 8192, R, C); const int Rb = E.perm ? ((R & ~31) + perm32(R & 31)) : R;
        voffA[i] = (unsigned)(R * g.lda + C) * 2u; voffB[i] = (unsigned)(Rb * g.ldb + C) * 2u; }
    const size_t kstep = (size_t)(BK * 2);
    const size_t hstepA = (size_t)HALF * g.lda * 2, hstepB = (size_t)HALF * g.ldb * 2;
    const size_t tstepA = 2 * hstepA, tstepB = 2 * hstepB;
    const unsigned ldsw = (unsigned)wid * 1024u;
    const int aoff = lds_byte(wr * 64 + fr, fq * 8), boff = lds_byte(wc * 32 + fr, fq * 8);
#define PG8_SA(b, h) (((b) * 2 + (h)) * HTB)
#define PG8_SB(b, h) ((4 + (b) * 2 + (h)) * HTB)
#define PG8_STAGE(bufoff, gbase, voff) do { _Pragma("unroll") for (int _i = 0; _i < 2; ++_i) \
        __builtin_amdgcn_global_load_lds((const unsigned*)((const char*)(gbase) + (voff)[_i]), (PG8_LAS unsigned*)(lds + (bufoff) + ldsw + _i * 8192), 16, 0, 0); } while (0)
#define PG8_LDA(dst, b, h) do { _Pragma("unroll") for (int m = 0; m < 4; ++m) _Pragma("unroll") for (int k = 0; k < 2; ++k) dst[m][k] = *(const PG8_LAS bf16x8*)(lds + PG8_SA(b, h) + aoff + m * 2048 + k * 1024); } while (0)
#define PG8_LDB(dst, b, h) do { _Pragma("unroll") for (int n = 0; n < 2; ++n) _Pragma("unroll") for (int k = 0; k < 2; ++k) dst[n][k] = *(const PG8_LAS bf16x8*)(lds + PG8_SB(b, h) + boff + n * 2048 + k * 1024); } while (0)
#define PG8_MMA(ai, bj, At, Bt) do { __builtin_amdgcn_s_setprio(1); _Pragma("unroll") for (int m = 0; m < 4; ++m) _Pragma("unroll") for (int n = 0; n < 2; ++n) _Pragma("unroll") for (int k = 0; k < 2; ++k) \
        acc[ai][bj][m][n] = __builtin_amdgcn_mfma_f32_16x16x32_bf16(Bt[n][k], At[m][k], acc[ai][bj][m][n], 0, 0, 0); __builtin_amdgcn_s_setprio(0); } while (0)
#define PG8_WAIT_V(n) asm volatile("s_waitcnt vmcnt(" #n ")" ::: "memory")
#define PG8_WAIT_L(n) asm volatile("s_waitcnt lgkmcnt(" #n ")" ::: "memory")
#define PG8_BAR __builtin_amdgcn_s_barrier()
#define PG8_SCHED __builtin_amdgcn_sched_barrier(0)
    Unit cur, nxt; int ui = 0;
    if (!S.next(0, cur)) return;
    f32x4 acc[2][2][4][2];
#pragma unroll
    for (int a = 0; a < 2; ++a)
#pragma unroll
        for (int b = 0; b < 2; ++b)
#pragma unroll
            for (int m = 0; m < 4; ++m)
#pragma unroll
                for (int n = 0; n < 2; ++n) acc[a][b][m][n] = (f32x4){0.f, 0.f, 0.f, 0.f};
    bf16x8 At[4][2], B0[2][2], B1[2][2];
    const char* cA = (const char*)g.A + (size_t)cur.pm * tstepA; const char* cB = (const char*)g.Bt + (size_t)cur.pn * tstepB;
    S.a_ready(cur);
    if constexpr (SP2) {
        PG8_STAGE(PG8_SB(0, 0), cB, voffB); PG8_STAGE(PG8_SB(0, 1), cB + hstepB, voffB); PG8_STAGE(PG8_SA(0, 0), cA, voffA); PG8_STAGE(PG8_SA(0, 1), cA + hstepA, voffA);
        if (wr == 1) PG8_BAR;
        PG8_WAIT_V(2); PG8_BAR;
        PG8_STAGE(PG8_SB(1, 0), cB + kstep, voffB); PG8_STAGE(PG8_SA(1, 0), cA + kstep, voffA); PG8_STAGE(PG8_SB(1, 1), cB + hstepB + kstep, voffB);
        PG8_WAIT_V(6); PG8_BAR;
    } else {
        PG8_STAGE(PG8_SB(0, 0), cB, voffB); PG8_STAGE(PG8_SA(0, 0), cA, voffA); PG8_STAGE(PG8_SB(0, 1), cB + hstepB, voffB); PG8_STAGE(PG8_SA(0, 1), cA + hstepA, voffA);
        if (wr == 1) PG8_BAR;
        PG8_WAIT_V(4); PG8_BAR;
        PG8_STAGE(PG8_SB(1, 0), cB + kstep, voffB); PG8_STAGE(PG8_SA(1, 0), cA + kstep, voffA); PG8_STAGE(PG8_SB(1, 1), cB + hstepB + kstep, voffB);
        PG8_WAIT_V(6); PG8_BAR;
    }
    for (;;) {
        const bool has_next = S.next(ui + 1, nxt);
        const char* nA = has_next ? (const char*)g.A + (size_t)nxt.pm * tstepA : cA; const char* nB = has_next ? (const char*)g.Bt + (size_t)nxt.pn * tstepB : cB;
        for (int t = 0; t < nt; t += 2) {
            const bool last = (t == nt - 2);
            const char* a1 = cA + (size_t)(t + 1) * kstep;
            const char* a2 = last ? nA : cA + (size_t)(t + 2) * kstep; const char* b2 = last ? nB : cB + (size_t)(t + 2) * kstep;
            const char* a3 = a2 + kstep; const char* b3 = b2 + kstep;
            if (last && has_next) S.a_ready(nxt);
            if constexpr (SP2) {
            PG8_LDB(B0, 0, 0); PG8_LDB(B1, 0, 1); PG8_SCHED; PG8_LDA(At, 0, 0); PG8_STAGE(PG8_SA(1, 1), a1 + hstepA, voffA);
            PG8_WAIT_V(8); PG8_WAIT_L(0); PG8_BAR; PG8_MMA(0, 0, At, B0); PG8_MMA(0, 1, At, B1); PG8_BAR; PG8_SCHED;
            PG8_LDA(At, 0, 1); PG8_STAGE(PG8_SB(0, 0), b2, voffB); PG8_STAGE(PG8_SB(0, 1), b2 + hstepB, voffB); PG8_STAGE(PG8_SA(0, 0), a2, voffA);
            PG8_WAIT_V(8); PG8_WAIT_L(0); PG8_BAR; PG8_MMA(1, 0, At, B0); PG8_MMA(1, 1, At, B1); PG8_BAR; PG8_SCHED;
            PG8_LDB(B0, 1, 0); PG8_LDB(B1, 1, 1); PG8_SCHED; PG8_LDA(At, 1, 0); PG8_STAGE(PG8_SA(0, 1), a2 + hstepA, voffA);
            PG8_WAIT_V(8); PG8_WAIT_L(0); PG8_BAR; PG8_MMA(0, 0, At, B0); PG8_MMA(0, 1, At, B1); PG8_BAR; PG8_SCHED;
            PG8_LDA(At, 1, 1); PG8_STAGE(PG8_SB(1, 0), b3, voffB); PG8_STAGE(PG8_SB(1, 1), b3 + hstepB, voffB); PG8_STAGE(PG8_SA(1, 0), a3, voffA);
            PG8_WAIT_V(8); PG8_WAIT_L(0); PG8_BAR; PG8_MMA(1, 0, At, B0); PG8_MMA(1, 1, At, B1); PG8_BAR; PG8_SCHED;
            } else {
            PG8_LDB(B0, 0, 0); PG8_SCHED; PG8_LDA(At, 0, 0); PG8_STAGE(PG8_SA(1, 1), a1 + hstepA, voffA);
            PG8_WAIT_L(8); PG8_BAR; PG8_WAIT_L(0); PG8_MMA(0, 0, At, B0); PG8_BAR; PG8_SCHED;
            PG8_LDB(B1, 0, 1); PG8_STAGE(PG8_SB(0, 0), b2, voffB);
            PG8_BAR; PG8_WAIT_L(0); PG8_MMA(0, 1, At, B1); PG8_BAR;
            PG8_LDA(At, 0, 1); PG8_STAGE(PG8_SA(0, 0), a2, voffA);
            PG8_BAR; PG8_WAIT_L(0); PG8_MMA(1, 0, At, B0); PG8_BAR; PG8_SCHED;
            PG8_STAGE(PG8_SB(0, 1), b2 + hstepB, voffB);
            PG8_WAIT_V(6); PG8_BAR; PG8_MMA(1, 1, At, B1); PG8_BAR;
            PG8_LDB(B0, 1, 0); PG8_SCHED; PG8_LDA(At, 1, 0); PG8_STAGE(PG8_SA(0, 1), a2 + hstepA, voffA);
            PG8_WAIT_L(8); PG8_BAR; PG8_WAIT_L(0); PG8_MMA(0, 0, At, B0); PG8_BAR; PG8_SCHED;
            PG8_LDB(B1, 1, 1); PG8_STAGE(PG8_SB(1, 0), b3, voffB);
            PG8_BAR; PG8_WAIT_L(0); PG8_MMA(0, 1, At, B1); PG8_BAR;
            PG8_LDA(At, 1, 1); PG8_STAGE(PG8_SA(1, 0), a3, voffA);
            PG8_BAR; PG8_WAIT_L(0); PG8_MMA(1, 0, At, B0); PG8_BAR; PG8_SCHED;
            PG8_STAGE(PG8_SB(1, 1), b3 + hstepB, voffB);
            PG8_WAIT_V(6); PG8_BAR; PG8_MMA(1, 1, At, B1); PG8_BAR;
            }
        }
        if constexpr (ALIGN_EPI) { if (wr == 0) PG8_BAR; }
        if constexpr (!Epi::AFTER_DRAIN) { E(acc, cur, wr, wc, fr, fq); S.done(cur); }
        if (!has_next) break;
#pragma unroll
        for (int a = 0; a < 2; ++a)
#pragma unroll
            for (int b = 0; b < 2; ++b)
#pragma unroll
                for (int m = 0; m < 4; ++m)
#pragma unroll
                    for (int n = 0; n < 2; ++n) acc[a][b][m][n] = (f32x4){0.f, 0.f, 0.f, 0.f};
        cur = nxt; cA = nA; cB = nB; ++ui;
        if constexpr (ALIGN_EPI) { if (wr == 1) PG8_BAR; }
    }
    PG8_WAIT_V(0);
    if constexpr (!ALIGN_EPI) { if (wr == 0) PG8_BAR; }
    PG8_BAR;
    if constexpr (Epi::AFTER_DRAIN) { E.fused(acc, cur, wr, wc, fr, fq, lds, wid, lane); S.done(cur); }
#undef PG8_SA
#undef PG8_SB
#undef PG8_STAGE
#undef PG8_LDA
#undef PG8_LDB
#undef PG8_MMA
#undef PG8_WAIT_V
#undef PG8_WAIT_L
#undef PG8_BAR
#undef PG8_SCHED
}

}
using pg8::Unit; using pg8::cvt_pk_bf16;
typedef unsigned u32x4 __attribute__((ext_vector_type(4)));
typedef unsigned u32x2 __attribute__((ext_vector_type(2)));
__device__ __forceinline__ float quad_sum(float s) { s += __shfl_xor(s, 16); s += __shfl_xor(s, 32); return s; }
__device__ __forceinline__ u32x4 pack8bf(f32x4 a, f32x4 b) { u32x4 w; w.x = cvt_pk_bf16(a[0], a[1]); w.y = cvt_pk_bf16(a[2], a[3]); w.z = cvt_pk_bf16(b[0], b[1]); w.w = cvt_pk_bf16(b[2], b[3]); return w; }
__device__ __forceinline__ float sq8(f32x4 a, f32x4 b) { return (a[0] * a[0] + a[1] * a[1]) + (a[2] * a[2] + a[3] * a[3]) + (b[0] * b[0] + b[1] * b[1]) + (b[2] * b[2] + b[3] * b[3]); }
#define EPI_ARGS const f32x4 (&acc)[2][2][4][2], const Unit& u, int wr, int wc, int fr, int fq
#define EPI_ROWS _Pragma("unroll") for (int ai = 0; ai < 2; ++ai) _Pragma("unroll") for (int m = 0; m < 4; ++m)

struct GEpiProj { static constexpr bool PERM = true, AFTER_DRAIN = false; bf16_t* proj; float* ssq_lat; float* gab;
    __device__ __forceinline__ void operator()(EPI_ARGS) const {
        const int row0 = u.pm * 256 + wr * 64 + fr, col0 = u.pn * 256 + wc * 32 + 8 * fq;
        EPI_ROWS { const int row = row0 + ai * 128 + m * 16; bf16_t* rowp = proj + (size_t)row * NPROJ + col0; float s = 0.f;
#pragma unroll
            for (int bj = 0; bj < 2; ++bj) { const f32x4 v0 = acc[ai][bj][m][0], v1 = acc[ai][bj][m][1]; if (!(u.pn == 10 && bj == 1)) *(u32x4*)(rowp + bj * 128) = pack8bf(v0, v1);     s += sq8(v0, v1);
                if (bj == 0 && u.pn == 10 && wc == 2 && fq == 0) { *(f32x4*)(gab + (size_t)row * 8) = v0; *(f32x4*)(gab + (size_t)row * 8 + 4) = v1; } }
            if (u.pn < 2) { s = quad_sum(s); if (fq == 0) unsafeAtomicAdd(&ssq_lat[row * 2 + u.pn], s); } }
    } };
struct GEpiQ { static constexpr bool PERM = true, AFTER_DRAIN = false; const float* ssq_lat; bf16_t* qraw; float* ssq_qk;
    __device__ __forceinline__ void operator()(EPI_ARGS) const {
        const int row0 = u.pm * 256 + wr * 64 + fr, col0 = u.pn * 256 + wc * 32 + 8 * fq;
        EPI_ROWS { const int row = row0 + ai * 128 + m * 16; const float rs = __builtin_amdgcn_rsqf(ssq_lat[row * 2] * (1.f / 256) + EPS); bf16_t* rowp = qraw + (size_t)row * 768 + col0;
#pragma unroll
            for (int bj = 0; bj < 2; ++bj) { const f32x4 v0 = acc[ai][bj][m][0] * rs, v1 = acc[ai][bj][m][1] * rs; *(u32x4*)(rowp + bj * 128) = pack8bf(v0, v1);
            } }
    } };
struct GEpiKV { static constexpr bool PERM = true, AFTER_DRAIN = false; const float* ssq_lat; bf16_t* kraw; bf16_t* V; float* ssq_qk;
    __device__ __forceinline__ void operator()(EPI_ARGS) const {
        const int row0 = u.pm * 256 + wr * 64 + fr, h = u.pn, cw = wc * 32 + 8 * fq;
        EPI_ROWS { const int row = row0 + ai * 128 + m * 16; const float rs = __builtin_amdgcn_rsqf(ssq_lat[row * 2 + 1] * (1.f / 256) + EPS);
            { const f32x4 v0 = acc[ai][0][m][0] * rs, v1 = acc[ai][0][m][1] * rs; *(u32x4*)(kraw + (size_t)row * 512 + h * 128 + cw) = pack8bf(v0, v1);
            }
            { const f32x4 v0 = acc[ai][1][m][0] * rs, v1 = acc[ai][1][m][1] * rs; const int b = row / SEQ, s = row % SEQ;
              *(u32x4*)(V + ((size_t)(b * 4 + h) * SEQ + s) * 128 + cw) = pack8bf(v0, v1); } }
    } };
struct GEpiOut { static constexpr bool PERM = false, AFTER_DRAIN = false; const float* x; float* out; bf16_t* hb; float* ssq_h;
    __device__ __forceinline__ void operator()(EPI_ARGS) const {
        const int row0 = u.pm * 256 + wr * 64 + fr, col0 = u.pn * 256 + wc * 32 + 4 * fq;
        EPI_ROWS { const int row = row0 + ai * 128 + m * 16; const size_t off = (size_t)row * DM + col0; float s = 0.f;
#pragma unroll
            for (int bj = 0; bj < 2; ++bj)
#pragma unroll
                for (int n = 0; n < 2; ++n) { const size_t o = off + bj * 128 + n * 16; const f32x4 hv = *(const f32x4*)(x + o) + acc[ai][bj][m][n];
                    u32x2 w; w.x = cvt_pk_bf16(hv[0], hv[1]); w.y = cvt_pk_bf16(hv[2], hv[3]); *(u32x2*)(hb + o) = w; s += (hv[0] * hv[0] + hv[1] * hv[1]) + (hv[2] * hv[2] + hv[3] * hv[3]); }
            s = quad_sum(s); if (fq == 0) unsafeAtomicAdd(&ssq_h[row], s); }
    } };
struct GEpiUp { static constexpr bool PERM = true, AFTER_DRAIN = false; const float* ssq_h; bf16_t* act;
    __device__ __forceinline__ void operator()(EPI_ARGS) const {
        const int row0 = u.pm * 256 + wr * 64 + fr, col0 = u.pn * 256 + wc * 32 + 8 * fq;
        EPI_ROWS { const int row = row0 + ai * 128 + m * 16; const float rs = __builtin_amdgcn_rsqf(ssq_h[row] * (1.f / DM) + EPS); bf16_t* rowp = act + (size_t)row * DFF + col0;
#pragma unroll
            for (int bj = 0; bj < 2; ++bj) { f32x4 v0 = acc[ai][bj][m][0] * rs, v1 = acc[ai][bj][m][1] * rs;
#pragma unroll
                for (int r = 0; r < 4; ++r) { const float a = fmaxf(v0[r], 0.f), b = fmaxf(v1[r], 0.f); v0[r] = a * a; v1[r] = b * b; }
                *(u32x4*)(rowp + bj * 128) = pack8bf(v0, v1); } }
    } };
struct GEpiDown { static constexpr bool PERM = false, AFTER_DRAIN = false; float* out; const bf16_t* hb;
    __device__ __forceinline__ void operator()(EPI_ARGS) const {
        const int row0 = u.pm * 256 + wr * 64 + fr, col0 = u.pn * 256 + wc * 32 + 4 * fq;
        EPI_ROWS { const int row = row0 + ai * 128 + m * 16; const size_t off = (size_t)row * DM + col0;
#pragma unroll
            for (int bj = 0; bj < 2; ++bj)
#pragma unroll
                for (int n = 0; n < 2; ++n) { const size_t o = off + bj * 128 + n * 16; const u32x2 hw = *(const u32x2*)(hb + o);
                    const f32x4 hv = {__builtin_bit_cast(float, hw.x << 16), __builtin_bit_cast(float, hw.x & 0xffff0000u), __builtin_bit_cast(float, hw.y << 16), __builtin_bit_cast(float, hw.y & 0xffff0000u)};
                    *(f32x4*)(out + o) = hv + acc[ai][bj][m][n]; } }
    } };
struct GEpi { static constexpr bool AFTER_DRAIN = false; int kind; bool perm; unsigned char* ws; const float* x; float* out;
    __device__ __forceinline__ void operator()(EPI_ARGS) const {
        float* ssq_lat = (float*)(ws + WS_SMALL + SM_SSQ_LAT); float* ssq_qk = (float*)(ws + WS_SMALL + SM_SSQ_QK); float* ssq_h = (float*)(ws + WS_SMALL + SM_SSQ_H);
        switch (kind) {
        case 0: GEpiProj{(bf16_t*)(ws + WS_PROJ), ssq_lat, (float*)(ws + WS_GAB)}(acc, u, wr, wc, fr, fq); break;
        case 1: GEpiQ{ssq_lat, (bf16_t*)(ws + WS_QRAW), ssq_qk}(acc, u, wr, wc, fr, fq); break;
        case 2: GEpiKV{ssq_lat, (bf16_t*)(ws + WS_KRAW), (bf16_t*)(ws + WS_V), ssq_qk}(acc, u, wr, wc, fr, fq); break;
        case 3: GEpiOut{x, out, (bf16_t*)(ws + WS_HB), ssq_h}(acc, u, wr, wc, fr, fq); break;
        case 4: GEpiUp{ssq_h, (bf16_t*)(ws + WS_ACT)}(acc, u, wr, wc, fr, fq); break;
        default: GEpiDown{out, (const bf16_t*)(ws + WS_HB)}(acc, u, wr, wc, fr, fq); break;
        }
    } };

__device__ __forceinline__ int uq_orig_col(int n) { if (n < 512) return (n >> 7) * 192 + (n & 127); const int r = n - 512; return (r >> 6) * 192 + 128 + (r & 63); }
__device__ __forceinline__ void wt_item(const float* W, int K, int N, bf16_t* WT, const float* ksc, int perm, __attribute__((address_space(3))) float* scr, int item, int lane, int nblk) {
    const int kb = item / nblk, nb = item - kb * nblk, k0 = 64 * kb, np0 = 64 * nb; const int n0 = perm ? uq_orig_col(np0) : np0;
    const int rsub = lane >> 4, c4 = (lane & 15) * 4; const bool ok = n0 + c4 < N;
#pragma unroll
    for (int i = 0; i < 16; ++i) { const int kk = 4 * i + rsub; f32x4 v = ok ? *(const f32x4*)(W + (size_t)(k0 + kk) * N + n0 + c4) : (f32x4){0.f, 0.f, 0.f, 0.f}; if (ksc) v = v * ksc[k0 + kk];
        scr[kk * 65 + c4] = v.x; scr[kk * 65 + c4 + 1] = v.y; scr[kk * 65 + c4 + 2] = v.z; scr[kk * 65 + c4 + 3] = v.w; }
    const int c = lane & 7;
#pragma unroll
    for (int j = 0; j < 8; ++j) { const int nn = (lane >> 3) + 8 * j; const __attribute__((address_space(3))) float* s = scr + (8 * c) * 65 + nn;
        u32x4 o; o.x = cvt_pk_bf16(s[0 * 65], s[1 * 65]); o.y = cvt_pk_bf16(s[2 * 65], s[3 * 65]); o.z = cvt_pk_bf16(s[4 * 65], s[5 * 65]); o.w = cvt_pk_bf16(s[6 * 65], s[7 * 65]);
        *(u32x4*)(WT + (size_t)(np0 + nn) * K + k0 + 8 * c) = o; }
}
constexpr int WI0 = (DM / 64) * (NPROJ / 64), WI1 = (256 / 64) * (768 / 64), WI2 = (256 / 64) * (1024 / 64), WI3 = (DM / 64) * (DM / 64), WI4 = (DM / 64) * (DFF / 64), WI5 = (DFF / 64) * (DM / 64);
__device__ __forceinline__ void wt_range(const P& p, unsigned char* lds, int lo, int hi, int gw0, int nwv) {
    const int tix = opq_v(threadIdx.x); const int lane = tix & 63, wv = __builtin_amdgcn_readfirstlane(tix >> 6);
    __attribute__((address_space(3))) float* scr = (__attribute__((address_space(3))) float*)((__attribute__((address_space(3))) unsigned char*)lds + wv * 16640);
#pragma clang loop unroll(disable)
    for (int it = lo + gw0 + wv; it < hi; it += nwv) {
        int r = it; const float* W; const float* ksc = nullptr; bf16_t* WT; int K, N, nblk, perm = 0;
        if (r < WI0) { W = p.w_in; K = DM; N = DIN; nblk = NPROJ / 64; WT = WSP(bf16_t, WS_WIN); }
        else if ((r -= WI0) < WI1) { W = p.w_uq; K = 256; N = 768; nblk = 768 / 64; WT = WSP(bf16_t, WS_WUQ); ksc = p.q_lat_norm_w; perm = 1; }
        else if ((r -= WI1) < WI2) { W = p.w_ukv; K = 256; N = 1024; nblk = 1024 / 64; WT = WSP(bf16_t, WS_WUKV); ksc = p.kv_lat_norm_w; }
        else if ((r -= WI2) < WI3) { W = p.w_out; K = DM; N = DM; nblk = DM / 64; WT = WSP(bf16_t, WS_WOUT); }
        else if ((r -= WI3) < WI4) { W = p.w_up; K = DM; N = DFF; nblk = DFF / 64; WT = WSP(bf16_t, WS_WUP); ksc = p.mlp_norm_w; }
        else { r -= WI4; W = p.w_down; K = DFF; N = DM; nblk = DM / 64; WT = WSP(bf16_t, WS_WDOWN); }
        wt_item(W, K, N, WT, ksc, perm, scr, r, lane, nblk);
    }
}
__device__ __forceinline__ void ph_prologue(const P& p, unsigned char* lds) {
    const int tix = opq_v(threadIdx.x), bix = opq_s(blockIdx.x);
    const size_t gt = (size_t)bix * 512 + tix, gn = (size_t)gridDim.x * 512;
    for (size_t i = gt; i < SM_SSQ_QK / 4; i += gn) WSP(float, WS_SMALL)[i] = 0.f;
    for (size_t i = SM_SSQ_H / 4 + gt; i < SM_ZERO_BYTES / 4; i += gn) WSP(float, WS_SMALL)[i] = 0.f;
    const int lane = tix & 63, wv = __builtin_amdgcn_readfirstlane(tix >> 6), gw = bix * 8 + wv, nw = gridDim.x * 8;
    const bool defer = (gridDim.x == 256);
    wt_range(p, lds, 0, defer ? WI0 + WI1 + WI2 : WI0 + WI1 + WI2 + WI3 + WI4 + WI5, bix * 8, nw);

    bf16_t* XN = WSP(bf16_t, WS_XN);
    {
        f32x4 wv4[4], v[4], vn[4];
#pragma unroll
        for (int j = 0; j < 4; ++j) wv4[j] = ((const f32x4*)p.attn_norm_w)[lane + 64 * j];
        int m = gw;
        if (m < T) {
#pragma unroll
            for (int j = 0; j < 4; ++j) v[j] = ((const f32x4*)(p.x + (size_t)m * DM))[lane + 64 * j]; }
        for (; m < T; m += nw) {
            const int mn = m + nw < T ? m + nw : m;
#pragma unroll
            for (int j = 0; j < 4; ++j) vn[j] = ((const f32x4*)(p.x + (size_t)mn * DM))[lane + 64 * j];
            float s = 0.f;
#pragma unroll
            for (int j = 0; j < 4; ++j) s += v[j].x * v[j].x + v[j].y * v[j].y + v[j].z * v[j].z + v[j].w * v[j].w;
            const float rs = __builtin_amdgcn_rsqf(wave_sum(s) * (1.f / DM) + EPS);
#pragma unroll
            for (int j = 0; j < 4; ++j) { const f32x4 w = wv4[j]; const int c = (lane + 64 * j) * 4;
                u32x2 o; o.x = cvt_pk_bf16(v[j].x * rs * w.x, v[j].y * rs * w.y); o.y = cvt_pk_bf16(v[j].z * rs * w.z, v[j].w * rs * w.w);
                *(u32x2*)(XN + (size_t)m * DM + c) = o; v[j] = vn[j]; }
        }
    }
}
__device__ __forceinline__ void bf8_to_f(bf16x8 x, float* f) {
#pragma unroll
    for (int t = 0; t < 8; ++t) f[t] = bf2f((bf16_t)x[t]);
}
__device__ __forceinline__ void ph_qk_finalize(const P& p) {
    const int tix = opq_v(threadIdx.x), bix = opq_s(blockIdx.x);
    const int lane = tix & 63, gw = bix * 8 + (tix >> 6), nw = gridDim.x * 8;
    const bf16_t* QRAW = WSP(bf16_t, WS_QRAW); const bf16_t* KRAW = WSP(bf16_t, WS_KRAW); const bf16_t* PROJ = WSP(bf16_t, WS_PROJ);
    const float* ssq = WSP(float, WS_SMALL + SM_SSQ_QK); bf16_t* Q = WSP(bf16_t, WS_Q); bf16_t* Kc = WSP(bf16_t, WS_K);
    const int d8 = (lane & 15) * 8, hq = lane >> 4, hh = lane >> 5, j = lane & 31;
    float wq[8], wk[8];
#pragma unroll
    for (int t = 0; t < 8; ++t) { wq[t] = p.q_norm_w[d8 + t]; wk[t] = p.k_norm_w[d8 + t]; }
    const float wq1 = p.q_norm_w[128 + j], wq2 = p.q_norm_w[160 + j], wk1 = p.k_norm_w[128 + j], wk2 = p.k_norm_w[160 + j];
    const float invf = exp2f(-(float)j * (1.f / 32) * 13.287712379549449f);
    bf16x8 qv, kv, nqv, nkv; float s0 = 0, s1 = 0, s2 = 0, s3 = 0, ns0 = 0, ns1 = 0, ns2 = 0, ns3 = 0; bf16_t e0, e1, e2, e3, e4, e5, ne0, ne1, ne2, ne3, ne4, ne5; int ps, nps;
#define QKF_LOAD(M, QV, KV, S0, S1, S2, S3, E0, E1, E2, E3, E4, E5, PS) do { QV = *(const bf16x8*)(QRAW + (size_t)(M) * 768 + lane * 8); KV = *(const bf16x8*)(KRAW + (size_t)(M) * 512 + lane * 8); \
        const bf16_t* qr_ = QRAW + (size_t)(M) * 768 + 512 + hh * 128; const bf16_t* kr_ = PROJ + (size_t)(M) * NPROJ + OFF_KPE; \
        E0 = qr_[j]; E1 = qr_[32 + j]; E2 = qr_[64 + j]; E3 = qr_[96 + j]; E4 = kr_[j]; E5 = kr_[32 + j]; PS = p.positions[M]; } while (0)
    int m = gw;
    if (m < T) QKF_LOAD(m, qv, kv, s0, s1, s2, s3, e0, e1, e2, e3, e4, e5, ps);
    for (; m < T; m += nw) {
        const int mn = m + nw < T ? m + nw : m;
        QKF_LOAD(mn, nqv, nkv, ns0, ns1, ns2, ns3, ne0, ne1, ne2, ne3, ne4, ne5, nps);
        const int b = m / SEQ, s = m % SEQ;
        float fq8[8], fk8[8]; bf8_to_f(qv, fq8); bf8_to_f(kv, fk8);
        float sqn = 0.f, skn = 0.f;
#pragma unroll
        for (int t = 0; t < 8; ++t) { sqn += fq8[t] * fq8[t]; skn += fk8[t] * fk8[t]; }
        sqn = row16_sum(sqn); skn = row16_sum(skn);
        const float rq = __builtin_amdgcn_rsqf(sqn * (1.f / 128) + EPS), rk = __builtin_amdgcn_rsqf(skn * (1.f / 128) + EPS);
        const float a1 = bf2f(e0), a2 = bf2f(e1), b1 = bf2f(e2), b2 = bf2f(e3); float k1 = bf2f(e4), k2 = bf2f(e5);
        float sra = row16_sum(a1 * a1 + a2 * a2), srb = row16_sum(b1 * b1 + b2 * b2); sra += __shfl_xor(sra, 16); srb += __shfl_xor(srb, 16);
        const float ra = __builtin_amdgcn_rsqf(sra * (1.f / 64) + EPS), rb = __builtin_amdgcn_rsqf(srb * (1.f / 64) + EPS);
        const float ang = (float)ps * invf; float rev = ang * 0.15915494309189535f; rev -= floorf(rev);
        const float c = __builtin_amdgcn_cosf(rev), sn = __builtin_amdgcn_sinf(rev);
        float f[8]; const size_t o = ((size_t)(b * 4 + hq) * SEQ + s) * 192 + d8;
        for (int t = 0; t < 8; ++t) f[t] = fq8[t]; { u32x4 w; w.x = cvt_pk_bf16(f[0] * rq * wq[0], f[1] * rq * wq[1]); w.y = cvt_pk_bf16(f[2] * rq * wq[2], f[3] * rq * wq[3]); w.z = cvt_pk_bf16(f[4] * rq * wq[4], f[5] * rq * wq[5]); w.w = cvt_pk_bf16(f[6] * rq * wq[6], f[7] * rq * wq[7]); *(u32x4*)(Q + o) = w; }
        for (int t = 0; t < 8; ++t) f[t] = fk8[t]; { u32x4 w; w.x = cvt_pk_bf16(f[0] * rk * wk[0], f[1] * rk * wk[1]); w.y = cvt_pk_bf16(f[2] * rk * wk[2], f[3] * rk * wk[3]); w.z = cvt_pk_bf16(f[4] * rk * wk[4], f[5] * rk * wk[5]); w.w = cvt_pk_bf16(f[6] * rk * wk[6], f[7] * rk * wk[7]); *(u32x4*)(Kc + o) = w; }
        const float kss = wave_sum(k1 * k1 + k2 * k2) * 0.5f; const float rkk = __builtin_amdgcn_rsqf(kss * (1.f / 64) + EPS);
        k1 *= rkk * wk1; k2 *= rkk * wk2; const bf16_t ko1 = f2bf(k1 * c - k2 * sn), ko2 = f2bf(k2 * c + k1 * sn);
        const float p1 = a1 * ra * wq1, p2 = a2 * ra * wq2, r1 = b1 * rb * wq1, r2 = b2 * rb * wq2;
        const size_t o0 = ((size_t)(b * 4 + hh * 2) * SEQ + s) * 192 + 128, o1 = o0 + (size_t)SEQ * 192;
        Q[o0 + j] = f2bf(p1 * c - p2 * sn); Q[o0 + 32 + j] = f2bf(p2 * c + p1 * sn); Q[o1 + j] = f2bf(r1 * c - r2 * sn); Q[o1 + 32 + j] = f2bf(r2 * c + r1 * sn);
        Kc[o0 + j] = ko1; Kc[o0 + 32 + j] = ko2; Kc[o1 + j] = ko1; Kc[o1 + 32 + j] = ko2;
        qv = nqv; kv = nkv; e0 = ne0; e1 = ne1; e2 = ne2; e3 = ne3; e4 = ne4; e5 = ne5; ps = nps;
    }
#undef QKF_LOAD
}
__device__ __forceinline__ void ph_gdn_prep(const P& p) {
    const int tix = opq_v(threadIdx.x), bix = opq_s(blockIdx.x);
    const int lane = tix & 63, gw = bix * 8 + (tix >> 6), nw = gridDim.x * 8;
    const bf16_t* PROJ = WSP(bf16_t, WS_PROJ); const float* gab = WSP(float, WS_GAB);
    const int part = (lane >> 4) < 3 ? (lane >> 4) : 2, c8 = (lane & 15) * 8; const bool live = lane < 48;
    bf16_t* dstb = part == 0 ? WSP(bf16_t, WS_GQ) : (part == 1 ? WSP(bf16_t, WS_GK) : WSP(bf16_t, WS_GV));
#pragma clang loop unroll(disable)
    for (int item = gw; item < BATCH * 4 * 32; item += nw) {
        const int bh = item >> 5, run = item & 31, b = bh >> 2, h = bh & 3, s0 = run * 64; const int cw = part * 512 + h * 128 + c8;
        float w[4][8];
#pragma unroll
        for (int i = 0; i < 4; ++i)
#pragma unroll
            for (int t = 0; t < 8; ++t) w[i][t] = p.conv_w[i * 1536 + cw + t];
        const bf16_t* src = PROJ + ((size_t)b * SEQ + s0) * NPROJ + OFF_GQ + cw; bf16_t* dst = dstb + ((size_t)bh * SEQ + s0) * 128 + c8;
        float x1[8], x2[8], x3[8];
        if (s0 > 0) { bf8_to_f(*(const bf16x8*)(src - 3 * (size_t)NPROJ), x1); bf8_to_f(*(const bf16x8*)(src - 2 * (size_t)NPROJ), x2); bf8_to_f(*(const bf16x8*)(src - (size_t)NPROJ), x3); }
        else {
#pragma unroll
            for (int t = 0; t < 8; ++t) { x1[t] = 0.f; x2[t] = 0.f; x3[t] = 0.f; } }
        bf16x8 cur[8], nxt[8];
#pragma unroll
        for (int t = 0; t < 8; ++t) cur[t] = *(const bf16x8*)(src + (size_t)t * NPROJ);
#pragma clang loop unroll(disable)
        for (int sb = 0; sb < 8; ++sb) {
            if (sb < 7) {
#pragma unroll
                for (int t = 0; t < 8; ++t) nxt[t] = *(const bf16x8*)(src + (size_t)((sb + 1) * 8 + t) * NPROJ); }
#pragma unroll
            for (int u = 0; u < 8; ++u) {
                float x0[8]; bf8_to_f(cur[u], x0);
                float y[8], ss = 0.f;
#pragma unroll
                for (int t = 0; t < 8; ++t) { const float a = w[0][t] * x1[t] + w[1][t] * x2[t] + w[2][t] * x3[t] + w[3][t] * x0[t]; y[t] = a * __builtin_amdgcn_rcpf(1.f + __expf(-a)); ss += y[t] * y[t]; x1[t] = x2[t]; x2[t] = x3[t]; x3[t] = x0[t]; }
                ss = row16_sum(ss);
                const float sc = part == 0 ? __builtin_amdgcn_rsqf(ss + EPS) * 0.08838834764831845f : (part == 1 ? __builtin_amdgcn_rsqf(ss + EPS) : 1.f);
                u32x4 o; o.x = cvt_pk_bf16(y[0] * sc, y[1] * sc); o.y = cvt_pk_bf16(y[2] * sc, y[3] * sc); o.z = cvt_pk_bf16(y[4] * sc, y[5] * sc); o.w = cvt_pk_bf16(y[6] * sc, y[7] * sc);
                if (live) *(u32x4*)(dst + (size_t)(sb * 8 + u) * 128) = o;
            }
#pragma unroll
            for (int t = 0; t < 8; ++t) cur[t] = nxt[t];
        }
    }
    for (int idx = bix * 512 + tix; idx < T * 4; idx += (int)gridDim.x * 512) { const int m = idx >> 2, h = idx & 3, b = m / SEQ, s = m % SEQ;
        const float a = gab[m * 8 + h] + p.dt_bias[h]; const float sp = a > 20.f ? a : __logf(1.f + __expf(a));
        WSP(float, WS_GG)[(size_t)(b * 4 + h) * SEQ + s] = -__expf(p.a_log[h]) * sp;
        WSP(float, WS_GBETA)[(size_t)(b * 4 + h) * SEQ + s] = 1.f / (1.f + __expf(-gab[m * 8 + 4 + h])); }
}
namespace att {
#define LAS __attribute__((address_space(3)))
typedef float f32x16 __attribute__((ext_vector_type(16)));
typedef short s16x4 __attribute__((ext_vector_type(4)));
constexpr int KVBLK = 64, QBLK = 32, QB = 256;
constexpr int SHM_V = 64 * 128 * 2, SHM_K = 64 * 192 * 2, OFF_K = 2 * SHM_V, OFF_WS = OFF_K + 2 * SHM_K;
constexpr float SCALE = 0.07216878364870323f, THR = 8.f;
constexpr int NQR = 4, OFF_QS = OFF_WS + 8 * 64 * 4;
#define KSWZ(row, colB) ((row) * 384 + ((colB) ^ ((((row) >> 1) & 7) << 4)))
#define SBAR() __builtin_amdgcn_sched_barrier(0)
__device__ __forceinline__ int v_st(int k, int c) { const int kk = (k & ~0xC) | ((k & 4) << 1) | ((k & 8) >> 1); return ((kk >> 3) * 4 + (c >> 5)) * 512 + ((kk & 7) * 32 + (c & 31)) * 2; }
__device__ __forceinline__ int v_rd_base(int lane) { return ((lane & 3) << 3) | (((lane >> 2) & 3) << 6) | (((lane >> 4) & 1) << 5) | (((lane >> 5) & 1) << 8); }
constexpr int v_rd_off(int d0, int ks, int half) { return d0 * 512 + ks * 4096 + half * 2048; }
__device__ __forceinline__ int crow(int r, int hi) { return (r & 3) + 8 * (r >> 2) + 4 * hi; }
__device__ __forceinline__ unsigned cvtpk(float lo, float hi) { unsigned r; asm volatile("v_cvt_pk_bf16_f32 %0, %1, %2" : "=v"(r) : "v"(lo), "v"(hi)); return r; }
__device__ __forceinline__ void mask_tile(f32x16& p0, f32x16& p1, int dq) {
    const float NEG = -__builtin_inff();
#pragma unroll
    for (int r = 0; r < 16; ++r) { const int c = (r & 3) + 8 * (r >> 2); if (dq - c < 0) p0[r] = NEG; if (dq - c - 32 < 0) p1[r] = NEG; }
}
__device__ __forceinline__ void partialSM(f32x16& p0, f32x16& p1, float& m_reg, float& mn, float& alpha) {
    float pmax = p0[0];
#pragma unroll
    for (int r = 1; r < 16; ++r) pmax = fmaxf(pmax, p0[r]);
#pragma unroll
    for (int r = 0; r < 16; ++r) pmax = fmaxf(pmax, p1[r]);
    { auto rr = __builtin_amdgcn_permlane32_swap(__float_as_uint(pmax), __float_as_uint(pmax), false, false); pmax = fmaxf(__uint_as_float(rr[0]), __uint_as_float(rr[1])); }
    constexpr float C2 = 1.4426950408889634f * SCALE;
    if (__builtin_expect(__all((pmax - m_reg) * SCALE <= THR), 1)) { mn = m_reg; alpha = 1.f; }
    else { mn = fmaxf(m_reg, pmax); alpha = __builtin_amdgcn_exp2f((m_reg - mn) * C2); m_reg = mn; }
    const float mnL = -mn * C2;
#pragma unroll
    for (int r = 0; r < 16; ++r) p0[r] = fmaf(p0[r], C2, mnL);
#pragma unroll
    for (int r = 0; r < 16; ++r) p1[r] = fmaf(p1[r], C2, mnL);
#pragma unroll
    for (int r = 0; r < 16; ++r) p0[r] = __builtin_amdgcn_exp2f(p0[r]);
}
__device__ __forceinline__ void finishSM(f32x16& p0, f32x16& p1, float alpha, float& l_reg, bf16x8& pa0, bf16x8& pa1, bf16x8& pa2, bf16x8& pa3) {
#pragma unroll
    for (int r = 0; r < 16; ++r) p1[r] = __builtin_amdgcn_exp2f(p1[r]);
    float ps = 0;
#pragma unroll
    for (int r = 0; r < 16; ++r) ps += p0[r];
#pragma unroll
    for (int r = 0; r < 16; ++r) ps += p1[r];
    { auto rr = __builtin_amdgcn_permlane32_swap(__float_as_uint(ps), __float_as_uint(ps), false, false); ps = __uint_as_float(rr[0]) + __uint_as_float(rr[1]); }
    l_reg = l_reg * alpha + ps;
#define PK4(P, B_, OUT) do { unsigned a0 = cvtpk(P[B_+0], P[B_+1]), a1 = cvtpk(P[B_+2], P[B_+3]); unsigned b0 = cvtpk(P[B_+4], P[B_+5]), b1 = cvtpk(P[B_+6], P[B_+7]); \
        auto r0 = __builtin_amdgcn_permlane32_swap(a0, b0, false, false); auto r1 = __builtin_amdgcn_permlane32_swap(a1, b1, false, false); \
        u32x4 w = {r0[0], r1[0], r0[1], r1[1]}; OUT = __builtin_bit_cast(bf16x8, w); } while (0)
    PK4(p0, 0, pa0); PK4(p0, 8, pa1); PK4(p1, 0, pa2); PK4(p1, 8, pa3);
#undef PK4
}
template <int KB>
__device__ __forceinline__ void qkt(f32x16& p0, f32x16& p1, const LAS unsigned char* K_lds, int r32, int hi, const bf16x8* qr, const LAS unsigned char* qsp) {
    p0 = f32x16{}; p1 = f32x16{};
    const LAS unsigned char* kb[4];
#pragma unroll
    for (int dd = 0; dd < 4; ++dd) kb[dd] = K_lds + KB * SHM_K + KSWZ(r32, (dd * 16 + hi * 8) * 2);
#pragma unroll
    for (int d0 = 0; d0 < 12; ++d0) { const LAS unsigned char* a = kb[d0 & 3] + (d0 >> 2) * 128;
        const bf16x8 b0 = *(const LAS bf16x8*)a; const bf16x8 b1 = *(const LAS bf16x8*)(a + 32 * 384);
        bf16x8 qv; if (d0 < NQR) qv = qr[d0]; else qv = *(const LAS bf16x8*)(qsp + (d0 - NQR) * 1024);
        p0 = __builtin_amdgcn_mfma_f32_32x32x16_bf16(b0, qv, p0, 0, 0, 0);
        p1 = __builtin_amdgcn_mfma_f32_32x32x16_bf16(b1, qv, p1, 0, 0, 0); }
}
template <int VB>
__device__ __forceinline__ void pv_tile(f32x16* o, int vb0, bf16x8 pa0, bf16x8 pa1, bf16x8 pa2, bf16x8 pa3) {
#define TRRD(dst, off) asm volatile("ds_read_b64_tr_b16 %0, %1 offset:%2" : "=&v"(dst) : "v"(vb0), "i"(off) : "memory")
#define PV_D0(d0) do { s16x4 l0, l1, l2, l3, h0, h1, h2, h3; constexpr int b_ = VB * SHM_V + v_rd_off(d0, 0, 0); \
        TRRD(l0, b_); TRRD(h0, b_ + 2048); TRRD(l1, b_ + 4096); TRRD(h1, b_ + 6144); TRRD(l2, b_ + 8192); TRRD(h2, b_ + 10240); TRRD(l3, b_ + 12288); TRRD(h3, b_ + 14336); \
        asm volatile("s_waitcnt lgkmcnt(0)" ::: "memory"); SBAR(); \
        o[d0] = __builtin_amdgcn_mfma_f32_32x32x16_bf16(pa0, (bf16x8){l0[0], l0[1], l0[2], l0[3], h0[0], h0[1], h0[2], h0[3]}, o[d0], 0, 0, 0); \
        o[d0] = __builtin_amdgcn_mfma_f32_32x32x16_bf16(pa1, (bf16x8){l1[0], l1[1], l1[2], l1[3], h1[0], h1[1], h1[2], h1[3]}, o[d0], 0, 0, 0); \
        o[d0] = __builtin_amdgcn_mfma_f32_32x32x16_bf16(pa2, (bf16x8){l2[0], l2[1], l2[2], l2[3], h2[0], h2[1], h2[2], h2[3]}, o[d0], 0, 0, 0); \
        o[d0] = __builtin_amdgcn_mfma_f32_32x32x16_bf16(pa3, (bf16x8){l3[0], l3[1], l3[2], l3[3], h3[0], h3[1], h3[2], h3[3]}, o[d0], 0, 0, 0); } while (0)
    PV_D0(0); PV_D0(1); PV_D0(2); PV_D0(3);
#undef PV_D0
#undef TRRD
}
__device__ __forceinline__ void attn_unit(int bh, int qb, const bf16_t* __restrict__ Qg, const bf16_t* __restrict__ Kg, const bf16_t* __restrict__ Vg, bf16_t* MIX, const float* __restrict__ onw_g, LAS unsigned char* lds, int tid, unsigned* qctr, LAS int* qslot) {
    const int wid = __builtin_amdgcn_readfirstlane(tid >> 6), lane = tid & 63, r32 = lane & 31, hi = lane >> 5;
    const int P0 = qb * QB, NT = (P0 + QB) / KVBLK;
    const bf16_t* Kh = Kg + (size_t)bh * SEQ * 192; const bf16_t* Vh = Vg + (size_t)bh * SEQ * 128;
    const bf16_t* Qw = Qg + ((size_t)bh * SEQ + P0 + wid * QBLK + r32) * 192 + hi * 8;
    LAS unsigned char* V_lds = lds; LAS unsigned char* K_lds = lds + OFF_K;
    LAS float* ws = (LAS float*)(lds + OFF_WS) + wid * 64; LAS float* li_l = ws; LAS float* al_l = ws + 32;
    const int qlo = P0 + wid * QBLK, qm = qlo + r32 - 4 * hi;
    const int sr = tid >> 4, sc = (tid & 15) * 8, vst0 = v_st(sr, sc), vst1 = v_st(32 + sr, sc);
    int kws[3], kgo[3];
#pragma unroll
    for (int i = 0; i < 3; ++i) { const int id = tid + 512 * i, row = id / 24, c = id - row * 24; kws[i] = KSWZ(row, c * 16); kgo[i] = row * 192 + c * 8; }
    const int vb0 = (int)(uintptr_t)V_lds + v_rd_base(lane);
    bf16x8 st_v0, st_v1, st_k0, st_k1, st_k2;
#define VMW() asm volatile("s_waitcnt vmcnt(0)" ::: "memory")
#define SLOAD(k0) do { st_v0 = *(const bf16x8*)(Vh + (size_t)((k0) + sr) * 128 + sc); st_v1 = *(const bf16x8*)(Vh + (size_t)((k0) + 32 + sr) * 128 + sc); \
        st_k0 = *(const bf16x8*)(Kh + (size_t)(k0) * 192 + kgo[0]); st_k1 = *(const bf16x8*)(Kh + (size_t)(k0) * 192 + kgo[1]); st_k2 = *(const bf16x8*)(Kh + (size_t)(k0) * 192 + kgo[2]); } while (0)
#define SWRITE_K(bf) do { *(LAS bf16x8*)(K_lds + (bf) * SHM_K + kws[0]) = st_k0; *(LAS bf16x8*)(K_lds + (bf) * SHM_K + kws[1]) = st_k1; *(LAS bf16x8*)(K_lds + (bf) * SHM_K + kws[2]) = st_k2; } while (0)
#define SWRITE_V(bf) do { *(LAS bf16x8*)(V_lds + (bf) * SHM_V + vst0) = st_v0; *(LAS bf16x8*)(V_lds + (bf) * SHM_V + vst1) = st_v1; } while (0)
#define KBASE(t) ((t) * KVBLK)
#define MASKT(P0_, P1_, t) do { const int kb_ = KBASE(t); if (kb_ + KVBLK - 1 > qlo) mask_tile(P0_, P1_, qm - kb_); } while (0)
#define RESC(a) do { if (__any((a) < 1.f)) { if (hi == 0) al_l[r32] = (a); asm volatile("s_waitcnt lgkmcnt(0)" ::: "memory"); \
        _Pragma("unroll") for (int d_ = 0; d_ < 4; ++d_) _Pragma("unroll") for (int r = 0; r < 16; ++r) o[d_][r] *= al_l[crow(r, hi)]; } } while (0)
    bf16x8 qr[NQR]; LAS unsigned char* qsp = lds + OFF_QS + wid * ((12 - NQR) * 1024) + lane * 16;
#pragma unroll
    for (int d0 = 0; d0 < NQR; ++d0) qr[d0] = *(const bf16x8*)(Qw + d0 * 16);
#pragma unroll
    for (int d0 = NQR; d0 < 12; ++d0) { const bf16x8 t_ = *(const bf16x8*)(Qw + d0 * 16); *(LAS bf16x8*)(qsp + (d0 - NQR) * 1024) = t_; }
    SLOAD(0); VMW(); SWRITE_K(0); SWRITE_V(0);
    __syncthreads();
    float m_reg = -1e30f, l_reg = 0.f; f32x16 o[4] = {};
    f32x16 pA0, pA1; float mnA, alA; bf16x8 pa0, pa1, pa2, pa3;
#define STEP(t, BF) do { \
        if ((t) + 1 < NT) { SLOAD(KBASE((t) + 1)); } SBAR(); \
        qkt<BF>(pA0, pA1, K_lds, r32, hi, qr, qsp); \
        MASKT(pA0, pA1, (t)); partialSM(pA0, pA1, m_reg, mnA, alA); RESC(alA); \
        finishSM(pA0, pA1, alA, l_reg, pa0, pa1, pa2, pa3); SBAR(); \
        pv_tile<BF>(o, vb0, pa0, pa1, pa2, pa3); \
        if ((t) + 1 < NT) { VMW(); SWRITE_K(1 - BF); SWRITE_V(1 - BF); } \
        __syncthreads(); } while (0)
    for (int t = 0; t < NT; t += 2) { STEP(t, 0); STEP(t + 1, 1); }
#undef STEP
    int nxt_unit = 0; if (tid == 0) nxt_unit = (int)atomicAdd(qctr, 1u);
    if (hi == 0) li_l[r32] = l_reg;
    asm volatile("s_waitcnt lgkmcnt(0)" ::: "memory");
    const int b = bh >> 2, h = bh & 3;
    float wn[4];
#pragma unroll
    for (int d0 = 0; d0 < 4; ++d0) wn[d0] = onw_g[h * 128 + d0 * 32 + r32];
    bf16_t* Ow = MIX + ((size_t)b * SEQ + P0 + wid * QBLK) * DM + h * 128 + r32;
#pragma unroll
    for (int r = 0; r < 16; ++r) { const int orow = crow(r, hi); const float rl = __builtin_amdgcn_rcpf(li_l[orow]);
        float v[4], ss = 0.f;
#pragma unroll
        for (int d0 = 0; d0 < 4; ++d0) { v[d0] = o[d0][r] * rl; ss += v[d0] * v[d0]; }
        ss = row16_sum(ss); ss += __shfl_xor(ss, 16);
        const float rn = __builtin_amdgcn_rsqf(ss * (1.f / 128) + EPS);
#pragma unroll
        for (int d0 = 0; d0 < 4; ++d0) { const float val = v[d0] * rn * wn[d0]; const float vn = __builtin_bit_cast(float, __builtin_amdgcn_mov_dpp(__builtin_bit_cast(int, val), 0xB1, 0xF, 0xF, true));
            if ((r32 & 1) == 0) *(unsigned*)(Ow + (size_t)orow * DM + d0 * 32) = cvtpk(val, vn); } }
    if (tid == 0) *qslot = nxt_unit;
    __syncthreads();
#undef VMW
#undef SLOAD
#undef SWRITE_K
#undef SWRITE_V
#undef KBASE
#undef MASKT
#undef RESC
}
#undef SBAR
#undef KSWZ
#undef LAS
}

namespace gdn {
#define LAS __attribute__((address_space(3)))
typedef float f32x2_t __attribute__((ext_vector_type(2))); typedef __bf16 bf16x2_t __attribute__((ext_vector_type(2)));
__device__ __forceinline__ unsigned cvtpk(float lo, float hi) { const f32x2_t v = {lo, hi}; const bf16x2_t b = __builtin_convertvector(v, bf16x2_t); return __builtin_bit_cast(unsigned, b); }
__device__ __forceinline__ bf16x8 pack2(f32x4 a, f32x4 b) { u32x4 w = {cvtpk(a[0], a[1]), cvtpk(a[2], a[3]), cvtpk(b[0], b[1]), cvtpk(b[2], b[3])}; return __builtin_bit_cast(bf16x8, w); }
__device__ __forceinline__ float wave_incl_scan(float g, int lane) {
#pragma unroll
    for (int o = 1; o < 64; o <<= 1) { const int src_ = lane >= o ? lane - o : lane; const float t = __builtin_bit_cast(float, __builtin_amdgcn_ds_bpermute(src_ << 2, __builtin_bit_cast(int, g))); if (lane >= o) g += t; }
    return g;
}
__device__ __forceinline__ int kperm(int c) { const int u = c & 31; return (c & ~31) + ((u & 16) ? 8 * ((u - 16) >> 2) + 4 + (u & 3) : 8 * (u >> 2) + (u & 3)); }
__device__ __forceinline__ void scale8(bf16x8 x, float s, u32x4& o) {
    float f[8];
#pragma unroll
    for (int t = 0; t < 8; ++t) f[t] = bf2f((bf16_t)x[t]) * s;
    o.x = cvtpk(f[0], f[1]); o.y = cvtpk(f[2], f[3]); o.z = cvtpk(f[4], f[5]); o.w = cvtpk(f[6], f[7]);
}
constexpr int CL_LM = 64 * 68 * 4, CL_WAVE = CL_LM + 512;
__device__ __forceinline__ void cl_copy_out(const LAS unsigned char* X, bf16_t* dst, int lane) {
#pragma unroll 2
    for (int it = 0; it < 8; ++it) { const int id = it * 64 + lane, row = id >> 3, pc = id & 7; const u32x4 v = *(const LAS u32x4*)(X + row * 128 + pc * 16); *(u32x4*)(dst + (size_t)row * NPROJ + pc * 8) = v; }
}
__device__ __forceinline__ void chunk_local(const P& p, LAS unsigned char* lds, int tix, int bix) {
    const int lane = tix & 63, wid = __builtin_amdgcn_readfirstlane(tix >> 6), fr = lane & 15, fq = lane >> 4;
    LAS float* Lm = (LAS float*)(lds + wid * CL_WAVE); LAS float* Gl = Lm + 64 * 68; LAS float* Bl = Gl + 64; LAS bf16_t* X = (LAS bf16_t*)Lm;
    bf16_t* PROJ = WSP(bf16_t, WS_PROJ);
#pragma clang loop unroll(disable)
    for (int item = bix * 8 + wid; item < BATCH * 4 * 32; item += (int)gridDim.x * 8) {
        const int bh = item >> 5, c = item & 31, b = bh >> 2, h = bh & 3; const size_t t0 = (size_t)bh * SEQ + c * 64;
        bf16_t* kp = WSP(bf16_t, WS_GK) + t0 * 128; bf16_t* qp = WSP(bf16_t, WS_GQ) + t0 * 128; bf16_t* vp = WSP(bf16_t, WS_GV) + t0 * 128;
        bf16_t* orow = PROJ + ((size_t)b * SEQ + c * 64) * NPROJ + OFF_GQ + h * 128;
        const float G = wave_incl_scan(WSP(float, WS_GG)[t0 + lane], opq_v(lane));
        Gl[lane] = G; Bl[lane] = WSP(float, WS_GBETA)[t0 + lane];
        if (lane == 63) WSP(float, WS_CD)[item] = __expf(G);
        bf16x8 kf[4][4];
#pragma unroll
        for (int mt = 0; mt < 4; ++mt)
#pragma unroll
            for (int kt = 0; kt < 4; ++kt) kf[mt][kt] = *(const bf16x8*)(kp + (size_t)(16 * mt + fr) * 128 + 32 * kt + 8 * fq);
        bf16x8 qfa[4][4];
#pragma unroll
        for (int mt = 0; mt < 2; ++mt)
#pragma unroll
            for (int kt = 0; kt < 4; ++kt) qfa[mt][kt] = *(const bf16x8*)(qp + (size_t)(16 * mt + fr) * 128 + 32 * kt + 8 * fq);
#pragma unroll
        for (int mt = 0; mt < 4; ++mt) { const f32x4 Gi = *(const LAS f32x4*)(Gl + 16 * mt + 4 * fq);
            if (mt == 0) {
#pragma unroll
                for (int m2 = 2; m2 < 4; ++m2)
#pragma unroll
                    for (int kt = 0; kt < 4; ++kt) qfa[m2][kt] = *(const bf16x8*)(qp + (size_t)(16 * m2 + fr) * 128 + 32 * kt + 8 * fq); }
#pragma unroll
            for (int nt = 0; nt < 4; ++nt) { f32x4 acc = {0.f, 0.f, 0.f, 0.f};
                if (nt <= mt) {
#pragma unroll
                    for (int kt = 0; kt < 4; ++kt) acc = __builtin_amdgcn_mfma_f32_16x16x32_bf16(qfa[mt][kt], kf[nt][kt], acc, 0, 0, 0); }
                const int j = 16 * nt + fr; const float Gj = Gl[j]; const int pj = kperm(j);
#pragma unroll
                for (int r = 0; r < 4; ++r) { const int i = 16 * mt + 4 * fq + r; X[i * 64 + pj] = f2bf((i >= j) ? acc[r] * __expf(Gi[r] - Gj) : 0.f); } } }
        cl_copy_out((const LAS unsigned char*)X, orow + 64, lane);
#pragma unroll
        for (int mt = 0; mt < 4; ++mt) { const f32x4 Gi = *(const LAS f32x4*)(Gl + 16 * mt + 4 * fq), Bi = *(const LAS f32x4*)(Bl + 16 * mt + 4 * fq);
#pragma unroll
            for (int nt = 0; nt <= mt; ++nt) { f32x4 acc = {0.f, 0.f, 0.f, 0.f};
#pragma unroll
                for (int kt = 0; kt < 4; ++kt) acc = __builtin_amdgcn_mfma_f32_16x16x32_bf16(kf[mt][kt], kf[nt][kt], acc, 0, 0, 0);
                const int j = 16 * nt + fr; const float Gj = Gl[j];
#pragma unroll
                for (int r = 0; r < 4; ++r) { const int i = 16 * mt + 4 * fq + r; Lm[i * 68 + j] = (i > j) ? Bi[r] * acc[r] * __expf(Gi[r] - Gj) : 0.f; } } }
        asm volatile("" ::: "memory");
        {
            float Tc[64];
#pragma unroll
            for (int i = 0; i < 64; ++i) { float a = (lane == i) ? 1.f : 0.f;
#pragma unroll
                for (int j4 = 0; j4 < i; j4 += 4) { const f32x4 l4 = *(const LAS f32x4*)(Lm + i * 68 + j4);
#pragma unroll
                    for (int r = 0; r < 4; ++r) if (j4 + r < i) a -= l4[r] * Tc[j4 + r]; }
                Tc[i] = a; }
            asm volatile("" ::: "memory");
            const int pl = kperm(lane);
#pragma unroll
            for (int i = 0; i < 64; ++i) X[i * 64 + pl] = f2bf(Tc[i]);
        }
        cl_copy_out((const LAS unsigned char*)X, orow, lane);
        asm volatile("s_waitcnt vmcnt(0) lgkmcnt(0)" ::: "memory");
        {
            const float Glast = Gl[63]; const int scp = lane & 7; LAS bf16_t* X2 = (LAS bf16_t*)Lm;
#pragma clang loop unroll(disable)
            for (int hf = 0; hf < 4; ++hf) {
                bf16x8 q0[2], q1[2], k0[2], k1[2], v0[2], v1[2];
#pragma unroll
                for (int u = 0; u < 2; ++u) { const size_t ro = (size_t)((hf * 2 + u) * 8 + (lane >> 3)) * 128 + scp * 16;
                    q0[u] = *(const bf16x8*)(qp + ro); q1[u] = *(const bf16x8*)(qp + ro + 8); k0[u] = *(const bf16x8*)(kp + ro); k1[u] = *(const bf16x8*)(kp + ro + 8); v0[u] = *(const bf16x8*)(vp + ro); v1[u] = *(const bf16x8*)(vp + ro + 8); }
#pragma unroll
                for (int u = 0; u < 2; ++u) { const int row = (hf * 2 + u) * 8 + (lane >> 3); const float Gi = Gl[row], bi = Bl[row]; const float eg = __expf(Gi), ed = __expf(Glast - Gi);
                    const size_t ro = (size_t)row * 128 + scp * 16; const int pc = (scp >> 1) * 32 + (scp & 1) * 4;
                    u32x4 a_, b_;
                    scale8(q0[u], eg, a_); scale8(q1[u], eg, b_);
                    { bf16_t* d = qp + (size_t)row * 128 + pc; *(u32x2*)(d) = (u32x2){a_.x, a_.y}; *(u32x2*)(d + 8) = (u32x2){a_.z, a_.w}; *(u32x2*)(d + 16) = (u32x2){b_.x, b_.y}; *(u32x2*)(d + 24) = (u32x2){b_.z, b_.w}; }
                    scale8(k0[u], -eg * bi, a_); scale8(k1[u], -eg * bi, b_);
                    { bf16_t* d = kp + (size_t)row * 128 + pc; *(u32x2*)(d) = (u32x2){a_.x, a_.y}; *(u32x2*)(d + 8) = (u32x2){a_.z, a_.w}; *(u32x2*)(d + 16) = (u32x2){b_.x, b_.y}; *(u32x2*)(d + 24) = (u32x2){b_.z, b_.w}; }
                    scale8(v0[u], bi, a_); scale8(v1[u], bi, b_); *(u32x4*)(vp + ro) = a_; *(u32x4*)(vp + ro + 8) = b_;
                    const int pi = kperm(row);
#pragma unroll
                    for (int t = 0; t < 8; ++t) { X2[(scp * 16 + t) * 64 + pi] = f2bf(bf2f((bf16_t)k0[u][t]) * ed); X2[(scp * 16 + 8 + t) * 64 + pi] = f2bf(bf2f((bf16_t)k1[u][t]) * ed); } }
            }
            bf16_t* krow = orow + 512;
#pragma unroll 2
            for (int it = 0; it < 16; ++it) { const int id = it * 64 + lane, row = id >> 4, pcs = id & 15; const u32x4 v = *(const LAS u32x4*)((const LAS unsigned char*)X2 + row * 256 + pcs * 16); *(u32x4*)(krow + (size_t)row * NPROJ + pcs * 8) = v; }
        }
    }
}
constexpr int RS128 = 288, RS64 = 160;
constexpr int L_QG = 0, L_KG = L_QG + 64 * RS128, L_VV = L_KG + 64 * RS128, L_KDT = L_VV + 64 * RS128, L_TT = L_KDT + 128 * RS64, L_AI = L_TT + 64 * RS64, L_PART = L_AI + 64 * RS64, L_OT = L_PART + 2048, L_END = L_OT + 64 * RS128;
#define GSB() __builtin_amdgcn_sched_barrier(0)
__device__ __forceinline__ void scan(const P& p, LAS unsigned char* lds, int tix, int bh) {
    const int lane = tix & 63, w = __builtin_amdgcn_readfirstlane(tix >> 6), fr = lane & 15, fq = lane >> 4, e0 = 16 * w, b = bh >> 2, h = bh & 3;
    const int srow = tix >> 3, scp = tix & 7;
    const bf16_t* gq = WSP(bf16_t, WS_GQ) + ((size_t)bh * SEQ + srow) * 128 + scp * 16; const bf16_t* gk = WSP(bf16_t, WS_GK) + ((size_t)bh * SEQ + srow) * 128 + scp * 16;
    const bf16_t* gv = WSP(bf16_t, WS_GV) + ((size_t)bh * SEQ + srow) * 128 + scp * 16;
    const bf16_t* gt = WSP(bf16_t, WS_PROJ) + ((size_t)b * SEQ + srow) * NPROJ + OFF_GQ + h * 128;
    const bf16_t* gz = WSP(bf16_t, WS_PROJ) + ((size_t)b * SEQ + srow) * NPROJ + OFF_GZ + h * 128 + scp * 16;
    bf16_t* mo = WSP(bf16_t, WS_MIX) + ((size_t)b * SEQ + srow) * DM + 512 + h * 128 + scp * 16;
    const float* gcd = WSP(float, WS_CD) + bh * 32;
    const float nw = p.gdn_norm_w[e0 + fr];
    const LAS unsigned char* fbase128 = lds + fr * RS128 + fq * 16; const LAS unsigned char* fbase64 = lds + fr * RS64 + fq * 16;
    LAS unsigned char* kdt_dst = lds + L_KDT + (2 * srow + (scp >> 2)) * RS64 + (scp & 3) * 32;
    f32x4 S[8];
#pragma unroll
    for (int i = 0; i < 8; ++i) S[i] = (f32x4){0.f, 0.f, 0.f, 0.f};
    bf16x8 pq0, pq1, pk0, pk1, pv0, pv1, pT, pA, pd0, pd1, pz0, pz1; float cd = 1.f, cdn = 1.f;
#define PREFETCH(c) do { const size_t o_ = (size_t)(c) * 64 * 128; pq0 = *(const bf16x8*)(gq + o_); pq1 = *(const bf16x8*)(gq + o_ + 8); pk0 = *(const bf16x8*)(gk + o_); pk1 = *(const bf16x8*)(gk + o_ + 8); \
        pv0 = *(const bf16x8*)(gv + o_); pv1 = *(const bf16x8*)(gv + o_ + 8); const size_t t_ = (size_t)(c) * 64 * NPROJ; pT = *(const bf16x8*)(gt + t_ + scp * 8); pA = *(const bf16x8*)(gt + t_ + 64 + scp * 8); \
        pd0 = *(const bf16x8*)(gt + t_ + 512 + scp * 16); pd1 = *(const bf16x8*)(gt + t_ + 512 + scp * 16 + 8); cdn = gcd[c]; } while (0)
#define COPYIN() do { *(LAS bf16x8*)(lds + L_QG + srow * RS128 + scp * 32) = pq0; *(LAS bf16x8*)(lds + L_QG + srow * RS128 + scp * 32 + 16) = pq1; \
        *(LAS bf16x8*)(lds + L_KG + srow * RS128 + scp * 32) = pk0; *(LAS bf16x8*)(lds + L_KG + srow * RS128 + scp * 32 + 16) = pk1; \
        *(LAS bf16x8*)(lds + L_VV + srow * RS128 + scp * 32) = pv0; *(LAS bf16x8*)(lds + L_VV + srow * RS128 + scp * 32 + 16) = pv1; \
        *(LAS bf16x8*)(kdt_dst) = pd0; *(LAS bf16x8*)(kdt_dst + 16) = pd1; \
        *(LAS bf16x8*)(lds + L_TT + srow * RS64 + scp * 16) = pT; *(LAS bf16x8*)(lds + L_AI + srow * RS64 + scp * 16) = pA; cd = cdn; } while (0)
#define FR128(base, mt, kt) (*(const LAS bf16x8*)(fbase128 + (base) + (mt) * 16 * RS128 + (kt) * 64))
#define FR64(base, mt, kt) (*(const LAS bf16x8*)(fbase64 + (base) + (mt) * 16 * RS64 + (kt) * 64))
    PREFETCH(0);
    COPYIN();
    __syncthreads();
#pragma clang loop unroll(disable)
    for (int c = 0; c < 32; ++c) {
        const float cdc = cd;
        if (c + 1 < 32) PREFETCH(c + 1);
        pz0 = *(const bf16x8*)(gz + (size_t)c * 64 * NPROJ); pz1 = *(const bf16x8*)(gz + (size_t)c * 64 * NPROJ + 8);
        bf16x8 sb[4];
#pragma unroll
        for (int kt = 0; kt < 4; ++kt) sb[kt] = pack2(S[2 * kt], S[2 * kt + 1]);
        f32x4 R[4], O[4], VN[4]; bf16x8 f[8], g[8];
#define LD8_128(dst, base, kt0) do { _Pragma("unroll") for (int mt = 0; mt < 4; ++mt) { dst[mt * 2] = FR128(base, mt, kt0); dst[mt * 2 + 1] = FR128(base, mt, (kt0) + 1); } } while (0)
#define LD8_64(dst, base, mt0) do { _Pragma("unroll") for (int mt = 0; mt < 4; ++mt) { dst[mt * 2] = FR64(base, (mt0) + mt, 0); dst[mt * 2 + 1] = FR64(base, (mt0) + mt, 1); } } while (0)
#define MM8(ACC, fr_, B0, B1) do { _Pragma("unroll") for (int mt = 0; mt < 4; ++mt) ACC[mt] = __builtin_amdgcn_mfma_f32_16x16x32_bf16(fr_[mt * 2], B0, ACC[mt], 0, 0, 0); \
                                   _Pragma("unroll") for (int mt = 0; mt < 4; ++mt) ACC[mt] = __builtin_amdgcn_mfma_f32_16x16x32_bf16(fr_[mt * 2 + 1], B1, ACC[mt], 0, 0, 0); } while (0)
        GSB();
        LD8_128(f, L_KG, 0); LD8_128(g, L_KG, 2);
#pragma unroll
        for (int mt = 0; mt < 4; ++mt)
#pragma unroll
            for (int j = 0; j < 4; ++j) R[mt][j] = bf2f(*(const LAS bf16_t*)(lds + L_VV + (16 * mt + 4 * fq + j) * RS128 + (e0 + fr) * 2));
        GSB();
        MM8(R, f, sb[0], sb[1]); LD8_128(f, L_QG, 0);
        GSB();
        MM8(R, g, sb[2], sb[3]); LD8_128(g, L_QG, 2);
        GSB();
        bf16x8 rb[2] = {pack2(R[0], R[1]), pack2(R[2], R[3])};
#pragma unroll
        for (int mt = 0; mt < 4; ++mt) { VN[mt] = (f32x4){0.f, 0.f, 0.f, 0.f}; O[mt] = (f32x4){0.f, 0.f, 0.f, 0.f}; }
        MM8(O, f, sb[0], sb[1]); LD8_64(f, L_TT, 0);
        GSB();
        MM8(O, g, sb[2], sb[3]); LD8_64(g, L_AI, 0);
        GSB();
        MM8(VN, f, rb[0], rb[1]); LD8_64(f, L_KDT, 0);
        GSB();
        bf16x8 vb[2] = {pack2(VN[0], VN[1]), pack2(VN[2], VN[3])};
#pragma unroll
        for (int mt = 0; mt < 8; ++mt) S[mt] = S[mt] * cdc;
        MM8(O, g, vb[0], vb[1]); LD8_64(g, L_KDT, 4);
        GSB();
        MM8(S, f, vb[0], vb[1]);
        GSB();
        { f32x4* S4 = S + 4; MM8(S4, g, vb[0], vb[1]); }
        GSB();
#undef LD8_128
#undef LD8_64
#undef MM8
        LAS float* part = (LAS float*)(lds + L_PART);
#pragma unroll
        for (int mt = 0; mt < 4; ++mt) { f32x4 s4 = O[mt] * O[mt];
#pragma unroll
            for (int j = 0; j < 4; ++j) { s4[j] = row16_sum(s4[j]);
                *(LAS bf16_t*)(lds + L_OT + (16 * mt + 4 * fq + j) * RS128 + (e0 + fr) * 2) = f2bf(O[mt][j] * nw); }
            if (fr == 0) *(LAS f32x4*)(part + w * 64 + 16 * mt + 4 * fq) = s4; }
        __syncthreads();
        if (c + 1 < 32) COPYIN();
        {
            float tot = 0.f;
#pragma unroll
            for (int ww = 0; ww < 8; ++ww) tot += part[ww * 64 + srow];
            const float rn = __builtin_amdgcn_rsqf(tot * (1.f / 128) + EPS);
            const bf16x8 o0 = *(const LAS bf16x8*)(lds + L_OT + srow * RS128 + scp * 32), o1 = *(const LAS bf16x8*)(lds + L_OT + srow * RS128 + scp * 32 + 16);
            float fo[8], fz[8]; u32x4 r0, r1;
            bf8_to_f(o0, fo); bf8_to_f(pz0, fz);
#pragma unroll
            for (int t = 0; t < 8; ++t) fo[t] = fo[t] * rn * (fz[t] * __builtin_amdgcn_rcpf(1.f + __expf(-fz[t])));
            r0.x = cvtpk(fo[0], fo[1]); r0.y = cvtpk(fo[2], fo[3]); r0.z = cvtpk(fo[4], fo[5]); r0.w = cvtpk(fo[6], fo[7]);
            bf8_to_f(o1, fo); bf8_to_f(pz1, fz);
#pragma unroll
            for (int t = 0; t < 8; ++t) fo[t] = fo[t] * rn * (fz[t] * __builtin_amdgcn_rcpf(1.f + __expf(-fz[t])));
            r1.x = cvtpk(fo[0], fo[1]); r1.y = cvtpk(fo[2], fo[3]); r1.z = cvtpk(fo[4], fo[5]); r1.w = cvtpk(fo[6], fo[7]);
            *(u32x4*)(mo + (size_t)c * 64 * DM) = r0; *(u32x4*)(mo + (size_t)c * 64 * DM + 8) = r1;
        }
        __syncthreads();
    }
#undef PREFETCH
#undef COPYIN
#undef FR128
#undef FR64
}
#undef GSB
#undef LAS
}

__device__ __forceinline__ void ph_mixers(const P& p, unsigned char* lds) {
    const int tix = opq_v(threadIdx.x), bix = opq_s(blockIdx.x); const int G = (int)gridDim.x;
    __attribute__((address_space(3))) unsigned char* l3 = (__attribute__((address_space(3))) unsigned char*)lds;
#pragma clang loop unroll(disable)
    for (int s = bix; s < BATCH * 4; s += G) gdn::scan(p, l3, tix, (s & 7) * 8 + (s >> 3));

    const bool perx = (G % 8 == 0) && G >= 8;
    const int xq = perx ? (bix & 7) : 0; const int nunits = perx ? 64 : 512;
    unsigned* ctr = WSP(unsigned, WS_SMALL + SM_QCTR) + xq * 64;
    __attribute__((address_space(3))) int* slot = (__attribute__((address_space(3))) int*)(lds + 150016);
    if (tix == 0) *slot = (int)atomicAdd(ctr, 1u);
    __syncthreads();
    for (;;) {
        const int u = __builtin_amdgcn_readfirstlane(*slot);
        if (u >= nunits) break;
        const int bh = perx ? xq * 8 + (u & 7) : (u & 63), qb = 7 - (perx ? (u >> 3) : (u >> 6));
        att::attn_unit(bh, qb, WSP(bf16_t, WS_Q), WSP(bf16_t, WS_K), WSP(bf16_t, WS_V), WSP(bf16_t, WS_MIX), p.mla_out_norm_w, l3, tix, ctr, slot);
    }
}
__device__ __forceinline__ void ph_gdn_chunk_local(const P& p, unsigned char* lds) {
    const int tix = opq_v(threadIdx.x), bix = opq_s(blockIdx.x);
    gdn::chunk_local(p, (__attribute__((address_space(3))) unsigned char*)lds, tix, bix);
}

#define XLAS __attribute__((address_space(3)))
#define XB_TMO      128
#define XB_XCNT(j)  (256  + 64 * (j))
#define XB_XSUB(j)  (1280 + 64 * (j))
#define XB_XGEN(j)  (2304 + 64 * (j))
#define XB_TOP      3328
#define XB_TOPGEN   3392
#define XCD_BAR_WORDS 3456
#define XB_SPIN_CAP (1u << 18)

__device__ __forceinline__ unsigned xb_ld(unsigned* p)              { return __hip_atomic_load(p, __ATOMIC_RELAXED, __HIP_MEMORY_SCOPE_AGENT); }
__device__ __forceinline__ unsigned xb_add(unsigned* p, unsigned v) { return __hip_atomic_fetch_add(p, v, __ATOMIC_RELAXED, __HIP_MEMORY_SCOPE_AGENT); }
__device__ __forceinline__ unsigned xb_xcc_id() { return (unsigned)__builtin_amdgcn_s_getreg((3 << 11) | 20) & 0xFu; }
#define XB_SPIN(cond, bar) do { unsigned _sp = 0; while (cond) { __builtin_amdgcn_s_sleep(1); \
    if ((++_sp & 255u) == 0u) { if (xb_ld(&(bar)[XB_TMO])) break; if (_sp > XB_SPIN_CAP) { atomicAdd(&(bar)[XB_TMO], 1u); break; } } } } while (0)

struct XcdBarrier {
    unsigned* bar; unsigned x;
    volatile XLAS unsigned* st;
};

__device__ __forceinline__ XcdBarrier xcd_barrier_post(unsigned* bar, volatile XLAS unsigned* st) {
    XcdBarrier b; b.bar = bar; b.x = xb_xcc_id(); b.st = st;
    if (threadIdx.x == 0) (void)xb_add(&bar[XB_XCNT(b.x)], 1u);
    return b;
}
__device__ __forceinline__ void xcd_barrier_complete(unsigned* bar, unsigned x, unsigned& nloc, unsigned& nx) {
    const unsigned G = gridDim.x * gridDim.y * gridDim.z;
    unsigned sum, cnt, mine, sp = 0u;
    for (;;) {
        sum = 0u; cnt = 0u; mine = 0u;
#pragma unroll
        for (unsigned j = 0; j < 16; ++j) { const unsigned c = xb_ld(&bar[XB_XCNT(j)]); sum += c; cnt += (c > 0u) ? 1u : 0u; mine = (j == x) ? c : mine; }
        if (sum == G) break;
        __builtin_amdgcn_s_sleep(1);
        if ((++sp & 255u) == 0u) { if (xb_ld(&bar[XB_TMO])) break; if (sp > XB_SPIN_CAP) { atomicAdd(&bar[XB_TMO], 1u); break; } }
    }
    nloc = mine > 0u ? mine : 1u; nx = cnt > 0u ? cnt : 1u;
}

__device__ __forceinline__ void xcd_barrier(const XcdBarrier& b) {
    asm volatile("s_waitcnt vmcnt(0)" ::: "memory");
    __syncthreads();
    if (threadIdx.x == 0) {
        unsigned* bar = b.bar;
        __builtin_amdgcn_s_waitcnt(0);
        unsigned nloc = b.st[0], nx = b.st[1];
        if (nloc == 0u) { xcd_barrier_complete(bar, b.x, nloc, nx); b.st[0] = nloc; b.st[1] = nx; }
        const unsigned old = xb_add(&bar[XB_XSUB(b.x)], 1u);
        const unsigned gen = old / nloc;
        if (old + 1u == (gen + 1u) * nloc) {
            __builtin_amdgcn_fence(__ATOMIC_RELEASE, "agent");
            asm volatile("s_waitcnt vmcnt(0)" ::: "memory");
            const unsigned og = xb_add(&bar[XB_TOP], 1u);
            const unsigned tg = og / nx;
            if (og + 1u == (tg + 1u) * nx) xb_add(&bar[XB_TOPGEN], 1u);
            else XB_SPIN(xb_ld(&bar[XB_TOPGEN]) == tg, bar);
            __builtin_amdgcn_fence(__ATOMIC_ACQUIRE, "agent");
            xb_add(&bar[XB_XGEN(b.x)], 1u);
            asm volatile("s_waitcnt vmcnt(0)" ::: "memory");
        } else {
            XB_SPIN(xb_ld(&bar[XB_XGEN(b.x)]) == gen, bar);
            __builtin_amdgcn_fence(__ATOMIC_ACQUIRE, "agent");
            asm volatile("s_waitcnt vmcnt(0)" ::: "memory");
        }
    }
    __syncthreads();
}

constexpr int LDS_BYTES = 155648;
#define GBAR() do { XcdBarrier b_; b_.bar = WSP(unsigned, WS_BAR); b_.x = xb_xcc_id(); b_.st = (volatile XLAS unsigned*)((XLAS unsigned char*)lds + 150032); xcd_barrier(b_); } while (0)
__device__ __forceinline__ void gemm_group(const P& p, PG8_LAS unsigned char* l3, unsigned char* lds, int g_lo) {
#pragma clang loop unroll(disable)
    for (int gi = g_lo; gi < g_lo + 3; ++gi) {
        const bf16_t* A; const bf16_t* Bt; int lda, ldb, N, K; bool perm = true;
        switch (gi) {
        case 0: A = WSP(bf16_t, WS_XN); lda = DM; Bt = WSP(bf16_t, WS_WIN); ldb = DM; N = NPROJ; K = DM; break;
        case 1: A = WSP(bf16_t, WS_PROJ); lda = NPROJ; Bt = WSP(bf16_t, WS_WUQ); ldb = 256; N = 768; K = 256; break;
        case 2: A = WSP(bf16_t, WS_PROJ) + OFF_KVLAT; lda = NPROJ; Bt = WSP(bf16_t, WS_WUKV); ldb = 256; N = 1024; K = 256; break;
        case 3: A = WSP(bf16_t, WS_MIX); lda = DM; Bt = WSP(bf16_t, WS_WOUT); ldb = DM; N = DM; K = DM; perm = false; break;
        case 4: A = WSP(bf16_t, WS_HB); lda = DM; Bt = WSP(bf16_t, WS_WUP); ldb = DM; N = DFF; K = DM; break;
        default: A = WSP(bf16_t, WS_ACT); lda = DFF; Bt = WSP(bf16_t, WS_WDOWN); ldb = DFF; N = DM; K = DFF; perm = false; break;
        }
        pg8::Gemm g{A, Bt, T, N, K, lda, ldb}; pg8::StaticOrder S; S.init(T, N, (int)gridDim.x, (int)blockIdx.x);
        GEpi E{gi, perm, p.ws, p.x, p.out};
        pg8::gemm_phase<GEpi, pg8::StaticOrder, true, true>(l3, g, S, E);
        if (gridDim.x == 256 && blockIdx.x >= 128) {
            if (gi == 0) wt_range(p, lds, WI0 + WI1 + WI2, WI0 + WI1 + WI2 + WI3 + WI4, ((int)blockIdx.x - 128) * 8, 128 * 8);
            if (gi == 2) wt_range(p, lds, WI0 + WI1 + WI2 + WI3 + WI4, WI0 + WI1 + WI2 + WI3 + WI4 + WI5, ((int)blockIdx.x - 128) * 8, 128 * 8);
        }
        if (gi == 0 || gi == 3 || gi == 4) GBAR();
    }
}
__global__ void __launch_bounds__(512, 2) mega_fwd(P p) {
    extern __shared__ __attribute__((aligned(16))) unsigned char lds[];
    cg::grid_group grid = cg::this_grid();
    PG8_LAS unsigned char* l3 = (PG8_LAS unsigned char*)lds;
    volatile XLAS unsigned* bst = (volatile XLAS unsigned*)((XLAS unsigned char*)lds + 150032);
    if (threadIdx.x < 2) bst[threadIdx.x] = 0u;
    __syncthreads();
    (void)xcd_barrier_post(WSP(unsigned, WS_BAR), bst);

    ph_prologue(p, lds);

    GBAR();
    if (gridDim.x == 0x7fffffu) grid.sync();
    gemm_group(p, l3, lds, 0);
    ph_gdn_prep(p);

    GBAR();
    ph_qk_finalize(p);
    ph_gdn_chunk_local(p, lds);
    GBAR();
    ph_mixers(p, lds);
    GBAR();
    gemm_group(p, l3, lds, 3);
}

extern "C" void kernel_launch(void* const* d_in, const int* in_sizes, int n_in, void* d_out, int out_size, void* d_ws, size_t ws_size, hipStream_t stream) {
    static int grid_blocks = 0;
    if (!grid_blocks) {
        int dev = 0, cus = 0, per_cu = 0;
        (void)hipGetDevice(&dev); (void)hipDeviceGetAttribute(&cus, hipDeviceAttributeMultiprocessorCount, dev);
        (void)hipFuncSetAttribute((const void*)mega_fwd, hipFuncAttributeMaxDynamicSharedMemorySize, LDS_BYTES);
        (void)hipOccupancyMaxActiveBlocksPerMultiprocessor(&per_cu, (const void*)mega_fwd, 512, LDS_BYTES);
        if (per_cu < 1) { fprintf(stderr, "kernel_launch: occupancy query says %d blocks/CU\n", per_cu); per_cu = 1; }
        grid_blocks = cus * 1;
    }
    P p{};
    p.x = (const float*)d_in[0]; p.positions = (const int*)d_in[1]; p.attn_norm_w = (const float*)d_in[2]; p.w_in = (const float*)d_in[3];
    p.q_lat_norm_w = (const float*)d_in[4]; p.w_uq = (const float*)d_in[5]; p.kv_lat_norm_w = (const float*)d_in[6]; p.w_ukv = (const float*)d_in[7];
    p.q_norm_w = (const float*)d_in[8]; p.k_norm_w = (const float*)d_in[9]; p.mla_out_norm_w = (const float*)d_in[10]; p.conv_w = (const float*)d_in[11];
    p.a_log = (const float*)d_in[12]; p.dt_bias = (const float*)d_in[13]; p.gdn_norm_w = (const float*)d_in[14]; p.w_out = (const float*)d_in[15];
    p.mlp_norm_w = (const float*)d_in[16]; p.w_up = (const float*)d_in[17]; p.w_down = (const float*)d_in[18];
    p.out = (float*)d_out; p.ws = (unsigned char*)d_ws;
    (void)hipMemsetAsync(p.ws + WS_BAR, 0, BAR_BYTES, stream);
    void* args[] = {&p};
    hipError_t e = hipLaunchCooperativeKernel((const void*)mega_fwd, dim3(grid_blocks), dim3(512), args, LDS_BYTES, stream);
    if (e != hipSuccess) fprintf(stderr, "cooperative launch failed: %s (grid %d)\n", hipGetErrorString(e), grid_blocks);
}
```
